# Optimizing an MI355X kernel written in HIP

```python
import jax, jax.numpy as jnp
from jax import lax
import numpy as np

D_MODEL = 1024
BATCH = 8
SEQ = 4096
DEPTH = 4

N_MIXERS = 2
N_LAYERS_A = (DEPTH + 1) // 2
N_LAYERS_B = DEPTH // 2
MIX_WIDTH = D_MODEL
CONV_WIDTH = 3
CONV_GROUPS = 8
POOL_WINDOWS = (2, 4, 8, 16)
N_POOL_GROUPS = len(POOL_WINDOWS)
POOL_GROUP_DIM = MIX_WIDTH // N_POOL_GROUPS
PLE_DIM = 256
EPS = 1e-6

kernel_name = "hybrid_shortconv_pool_ple_trunk"


def rmsnorm(x, g):
    xf = x.astype(jnp.float32)
    r = lax.rsqrt(jnp.mean(xf * xf, axis=-1, keepdims=True) + EPS)
    return (xf * r).astype(x.dtype) * g


def causal_conv3(u, w):
    s = u.shape[1]
    up = jnp.pad(u, ((0, 0), (CONV_WIDTH - 1, 0), (0, 0)))
    return up[:, 0:s] * w[0] + up[:, 1:s + 1] * w[1] + up[:, 2:s + 2] * w[2]


def short_conv_mixer(h, w_in, w_conv, w_out):
    proj = h @ w_in
    b_g, c_g, v, z = jnp.split(proj, 4, axis=-1)
    y = b_g * causal_conv3(c_g * v, w_conv)
    return (jax.nn.silu(z) * y) @ w_out


def causal_window_mean(u, window):
    s = u.shape[1]
    cs = jnp.cumsum(u.astype(jnp.float32), axis=1)
    csp = jnp.pad(cs, ((0, 0), (window, 0), (0, 0)))
    win_sum = csp[:, window:window + s] - csp[:, 0:s]
    count = jnp.minimum(jnp.arange(1, s + 1, dtype=jnp.float32), float(window))
    return (win_sum / count[None, :, None]).astype(u.dtype)


def pool_mixer(h, w_in, w_grp, scale, w_out):
    proj = h @ w_in
    u, z = jnp.split(proj, 2, axis=-1)
    bsz, s, _ = u.shape
    u4 = u.reshape(bsz, s, N_POOL_GROUPS, POOL_GROUP_DIM)
    pooled = jnp.stack([causal_window_mean(u4[:, :, g], w) for g, w in enumerate(POOL_WINDOWS)], axis=2)
    d = pooled - u4
    mixed = jnp.einsum('bsgc,gcd->bsgd', d, w_grp).reshape(bsz, s, MIX_WIDTH) * scale
    return (jax.nn.silu(z) * mixed) @ w_out


def setup_inputs(seed: int = 0) -> dict:
    key = jax.random.key(seed)
    ks = jax.random.split(key, 16)
    f32 = jnp.float32
    E, D, G = MIX_WIDTH, D_MODEL, POOL_GROUP_DIM
    nrm = lambda k, shape, fan_in: jax.random.normal(k, shape, f32) * (fan_in ** -0.5)
    gain = lambda k, shape: 1.0 + 0.02 * jax.random.normal(k, shape, f32)
    return {
        "x": jax.random.normal(ks[0], (BATCH, SEQ, D), f32),
        "p": jax.random.normal(ks[1], (DEPTH, BATCH, SEQ, PLE_DIM), f32),
        "norm_mix": gain(ks[2], (DEPTH, D)),
        "a_w_in": nrm(ks[3], (N_LAYERS_A, D, 4 * E), D),
        "a_w_conv": nrm(ks[4], (N_LAYERS_A, CONV_WIDTH, E), CONV_WIDTH),
        "a_w_out": nrm(ks[5], (N_LAYERS_A, E, D), E),
        "b_w_in": nrm(ks[6], (N_LAYERS_B, D, 2 * E), D),
        "b_w_grp": nrm(ks[7], (N_LAYERS_B, N_POOL_GROUPS, G, G), G),
        "b_scale": gain(ks[8], (N_LAYERS_B, E)),
        "b_w_out": nrm(ks[9], (N_LAYERS_B, E, D), E),
        "ple_norm": gain(ks[10], (DEPTH, D)),
        "ple_w_gate": nrm(ks[11], (DEPTH, D, D), D),
        "ple_w_proj": nrm(ks[12], (DEPTH, PLE_DIM, D), PLE_DIM),
        "final_norm": gain(ks[13], (D,)),
    }


def reference(x, p, norm_mix, a_w_in, a_w_conv, a_w_out, b_w_in, b_w_grp, b_scale, b_w_out,
              ple_norm, ple_w_gate, ple_w_proj, final_norm):
    h = x
    for i in range(DEPTH):
        hn = rmsnorm(h, norm_mix[i])
        j = i // N_MIXERS
        if i % N_MIXERS == 0:
            h = h + short_conv_mixer(hn, a_w_in[j], a_w_conv[j], a_w_out[j])
        else:
            h = h + pool_mixer(hn, b_w_in[j], b_w_grp[j], b_scale[j], b_w_out[j])
        gate = jax.nn.sigmoid(rmsnorm(h, ple_norm[i]) @ ple_w_gate[i])
        h = h + gate * (p[i] @ ple_w_proj[i])
    return rmsnorm(h, final_norm)
```

```cpp
#include <hip/hip_runtime.h>
#include <cstdio>
#include <cstdint>
namespace pg8 {
#define PG8_LAS __attribute__((address_space(3)))
typedef unsigned short bf16_t;
typedef short bf16x8 __attribute__((ext_vector_type(8)));
typedef float f32x4 __attribute__((ext_vector_type(4)));
typedef unsigned u32x4 __attribute__((ext_vector_type(4)));
constexpr int BM = 256, BK = 64, HALF = 128, HTB = HALF * BK * 2  , STAGE_BYTES = 8 * HTB, NXCD = 8, WGM = 8;

__host__ __device__ __forceinline__ int lds_byte(int r, int c) { const int st = (r >> 4) * 2 + (c >> 5), rr = r & 15, cc = c & 31, ob = rr * 64 + cc * 2; return st * 1024 + (ob ^ (((ob >> 9) & 1) << 5)); }
__host__ __device__ __forceinline__ void stage_rc(int b, int& R, int& C) { const int st = b / 1024, sb = b % 1024, swz = sb ^ (((sb >> 9) & 1) << 5); R = (st >> 1) * 16 + swz / 64; C = (st & 1) * 32 + (swz % 64) / 2; }
__host__ __device__ __forceinline__ int perm32(int rho) { const int n = rho >> 4, i = rho & 15; return 8 * (i >> 2) + 4 * n + (i & 3); }

struct Unit { int pm, pn; };
struct Gemm { const bf16_t* A; const bf16_t* Bt; int M, N, K; };

struct StaticOrder {
    int nM, nN, nwg, G, c;
    __host__ __device__ void init(int M, int N, int G_, int c_) { nM = M / BM; nN = N / BM; nwg = nM * nN; G = G_; c = c_; }
    __host__ __device__ bool next(int i, Unit& u) const {
        const long L = (long)i * G + c; if (L >= nwg) return false;
        int wgid = (int)L; { const int q = nwg / NXCD, r = nwg % NXCD, xcd = wgid % NXCD, off = wgid / NXCD; wgid = (xcd < r ? xcd * (q + 1) : r * (q + 1) + (xcd - r) * q) + off; }
        const int nig = WGM * nN, gid = wgid / nig, fm = gid * WGM, gsz = (nM - fm) < WGM ? (nM - fm) : WGM;
        u.pm = fm + ((wgid % nig) % gsz); u.pn = (wgid % nig) / gsz; return true;
    }
    __device__ __forceinline__ void a_ready(const Unit&) const {}
    __device__ __forceinline__ void done(const Unit&) const {}
};

__device__ __forceinline__ unsigned cvt_pk_bf16(float lo, float hi) { unsigned r; asm volatile("v_cvt_pk_bf16_f32 %0, %1, %2" : "=v"(r) : "v"(lo), "v"(hi)); return r; }
__device__ __forceinline__ float bf_lo(unsigned w) { return __builtin_bit_cast(float, w << 16); }
__device__ __forceinline__ float bf_hi(unsigned w) { return __builtin_bit_cast(float, w & 0xffff0000u); }
__device__ __forceinline__ float sigmoidf_fast(float x) { return __builtin_amdgcn_rcpf(1.0f + __builtin_amdgcn_exp2f(x * -1.44269504089f)); }
__device__ __forceinline__ float row_rs(const float* ssq, int row) {
    const f32x4* p = (const f32x4*)(ssq + (size_t)row * 16);
    const f32x4 a = p[0], b = p[1], c = p[2], d = p[3];
    const f32x4 s = (a + b) + (c + d);
    return __builtin_amdgcn_rsqf(((s[0] + s[1]) + (s[2] + s[3])) * (1.0f / 1024.0f) + 1e-6f);
}

struct EpiPlain {
    static constexpr bool PERM = true, AFTER_DRAIN = false;
    bf16_t* O; int ldc;
    __device__ __forceinline__ void operator()(const f32x4 (&acc)[2][2][4][2], const Unit& u, int wr, int wc, int fr, int fq) const {
        const int row0 = u.pm * BM + wr * 64 + fr, col0 = u.pn * BM + wc * 32 + 8 * fq;
#pragma unroll
        for (int ai = 0; ai < 2; ++ai)
#pragma unroll
            for (int m = 0; m < 4; ++m) { bf16_t* rowp = O + (size_t)(row0 + ai * HALF + m * 16) * ldc + col0;
#pragma unroll
                for (int bj = 0; bj < 2; ++bj) { const f32x4 v0 = acc[ai][bj][m][0], v1 = acc[ai][bj][m][1];
                    u32x4 w; w.x = cvt_pk_bf16(v0[0], v0[1]); w.y = cvt_pk_bf16(v0[2], v0[3]); w.z = cvt_pk_bf16(v1[0], v1[1]); w.w = cvt_pk_bf16(v1[2], v1[3]);
                    *(u32x4*)(rowp + bj * HALF) = w; } }
    }
};
struct EpiProj {
    static constexpr bool PERM = true, AFTER_DRAIN = false;
    bf16_t* O; int ldc; const float* ssq;
    __device__ __forceinline__ void operator()(const f32x4 (&acc)[2][2][4][2], const Unit& u, int wr, int wc, int fr, int fq) const {
        const int row0 = u.pm * BM + wr * 64 + fr, col0 = u.pn * BM + wc * 32 + 8 * fq;
#pragma unroll
        for (int ai = 0; ai < 2; ++ai)
#pragma unroll
            for (int m = 0; m < 4; ++m) { const int row = row0 + ai * HALF + m * 16; const float rs = row_rs(ssq, row); bf16_t* rowp = O + (size_t)row * ldc + col0;
#pragma unroll
                for (int bj = 0; bj < 2; ++bj) { const f32x4 v0 = acc[ai][bj][m][0] * rs, v1 = acc[ai][bj][m][1] * rs;
                    u32x4 w; w.x = cvt_pk_bf16(v0[0], v0[1]); w.y = cvt_pk_bf16(v0[2], v0[3]); w.z = cvt_pk_bf16(v1[0], v1[1]); w.w = cvt_pk_bf16(v1[2], v1[3]);
                    *(u32x4*)(rowp + bj * HALF) = w; } }
    }
};
struct EpiResid {
    static constexpr bool PERM = true, AFTER_DRAIN = false;
    const float* Hin; float* Hout; bf16_t* Hb; float* ssq_out;
    __device__ __forceinline__ void operator()(const f32x4 (&acc)[2][2][4][2], const Unit& u, int wr, int wc, int fr, int fq) const {
        const int row0 = u.pm * BM + wr * 64 + fr, col0 = u.pn * BM + wc * 32 + 8 * fq;
#pragma unroll
        for (int ai = 0; ai < 2; ++ai)
#pragma unroll
            for (int m = 0; m < 4; ++m) { const int row = row0 + ai * HALF + m * 16; const size_t off = (size_t)row * 1024 + col0; float s = 0.f;
#pragma unroll
                for (int bj = 0; bj < 2; ++bj) {
                    const f32x4 h0 = *(const f32x4*)(Hin + off + bj * HALF), h1 = *(const f32x4*)(Hin + off + bj * HALF + 4);
                    const f32x4 v0 = acc[ai][bj][m][0] + h0, v1 = acc[ai][bj][m][1] + h1;
                    *(f32x4*)(Hout + off + bj * HALF) = v0; *(f32x4*)(Hout + off + bj * HALF + 4) = v1;
                    u32x4 w; w.x = cvt_pk_bf16(v0[0], v0[1]); w.y = cvt_pk_bf16(v0[2], v0[3]); w.z = cvt_pk_bf16(v1[0], v1[1]); w.w = cvt_pk_bf16(v1[2], v1[3]);
                    *(u32x4*)(Hb + off + bj * HALF) = w;
                    s += ((v0[0] * v0[0] + v0[1] * v0[1]) + (v0[2] * v0[2] + v0[3] * v0[3])) + ((v1[0] * v1[0] + v1[1] * v1[1]) + (v1[2] * v1[2] + v1[3] * v1[3])); }
                s += __shfl_xor(s, 16); s += __shfl_xor(s, 32);
                if (fq == 0) ssq_out[(size_t)row * 16 + u.pn * 4 + wc] = s; }
    }
};
struct EpiPle {
    static constexpr bool PERM = true, AFTER_DRAIN = false;
    const float* Hin; float* Hout; bf16_t* Hb; const bf16_t* PP; const float* ssq_in; float* ssq_out;
    __device__ __forceinline__ void operator()(const f32x4 (&acc)[2][2][4][2], const Unit& u, int wr, int wc, int fr, int fq) const {
        const int row0 = u.pm * BM + wr * 64 + fr, col0 = u.pn * BM + wc * 32 + 8 * fq;
#pragma unroll
        for (int ai = 0; ai < 2; ++ai)
#pragma unroll
            for (int m = 0; m < 4; ++m) { const int row = row0 + ai * HALF + m * 16; const size_t off = (size_t)row * 1024 + col0; float s = 0.f; const float rs = row_rs(ssq_in, row);
#pragma unroll
                for (int bj = 0; bj < 2; ++bj) {
                    const u32x4 pw = *(const u32x4*)(PP + off + bj * HALF);
                    const f32x4 h0 = *(const f32x4*)(Hin + off + bj * HALF), h1 = *(const f32x4*)(Hin + off + bj * HALF + 4);
                    const f32x4 a0 = acc[ai][bj][m][0] * rs, a1 = acc[ai][bj][m][1] * rs;
                    f32x4 v0, v1;
                    v0[0] = h0[0] + sigmoidf_fast(a0[0]) * bf_lo(pw.x); v0[1] = h0[1] + sigmoidf_fast(a0[1]) * bf_hi(pw.x);
                    v0[2] = h0[2] + sigmoidf_fast(a0[2]) * bf_lo(pw.y); v0[3] = h0[3] + sigmoidf_fast(a0[3]) * bf_hi(pw.y);
                    v1[0] = h1[0] + sigmoidf_fast(a1[0]) * bf_lo(pw.z); v1[1] = h1[1] + sigmoidf_fast(a1[1]) * bf_hi(pw.z);
                    v1[2] = h1[2] + sigmoidf_fast(a1[2]) * bf_lo(pw.w); v1[3] = h1[3] + sigmoidf_fast(a1[3]) * bf_hi(pw.w);
                    *(f32x4*)(Hout + off + bj * HALF) = v0; *(f32x4*)(Hout + off + bj * HALF + 4) = v1;
                    u32x4 w; w.x = cvt_pk_bf16(v0[0], v0[1]); w.y = cvt_pk_bf16(v0[2], v0[3]); w.z = cvt_pk_bf16(v1[0], v1[1]); w.w = cvt_pk_bf16(v1[2], v1[3]);
                    *(u32x4*)(Hb + off + bj * HALF) = w;
                    s += ((v0[0] * v0[0] + v0[1] * v0[1]) + (v0[2] * v0[2] + v0[3] * v0[3])) + ((v1[0] * v1[0] + v1[1] * v1[1]) + (v1[2] * v1[2] + v1[3] * v1[3])); }
                s += __shfl_xor(s, 16); s += __shfl_xor(s, 32);
                if (fq == 0) ssq_out[(size_t)row * 16 + u.pn * 4 + wc] = s; }
    }
};
template <class Epi, class Sched, bool ALIGN_EPI = false, bool SP2 = false>
__device__ __forceinline__ void gemm_phase(PG8_LAS unsigned char* lds, const Gemm g, const Sched& S, const Epi& E) {
    int tid_o = threadIdx.x; asm volatile("" : "+v"(tid_o));
    const int tid = tid_o, wid = __builtin_amdgcn_readfirstlane(tid >> 6), lane = tid & 63, wr = wid >> 2, wc = wid & 3, fr = lane & 15, fq = lane >> 4;
    const int K = g.K, nt = K / BK;
    unsigned voffA[2], voffB[2];
#pragma unroll
    for (int i = 0; i < 2; ++i) { int R, C; stage_rc(tid * 16 + i * 8192, R, C); const int Rb = Epi::PERM ? ((R & ~31) + perm32(R & 31)) : R;
        voffA[i] = (unsigned)(R * K + C) * 2u; voffB[i] = (unsigned)(Rb * K + C) * 2u; }
    const size_t kstep = (size_t)(BK * 2);
    const size_t hstep = (size_t)HALF * K * 2;
    const size_t tstep = 2 * hstep;
    const unsigned ldsw = (unsigned)wid * 1024u;
    const int aoff = lds_byte(wr * 64 + fr, fq * 8), boff = lds_byte(wc * 32 + fr, fq * 8);
#define PG8_SA(b, h) (((b) * 2 + (h)) * HTB)
#define PG8_SB(b, h) ((4 + (b) * 2 + (h)) * HTB)
#define PG8_STAGE(bufoff, gbase, voff) do { _Pragma("unroll") for (int _i = 0; _i < 2; ++_i) \
        __builtin_amdgcn_global_load_lds((const unsigned*)((const char*)(gbase) + (voff)[_i]), (PG8_LAS unsigned*)(lds + (bufoff) + ldsw + _i * 8192), 16, 0, 0); } while (0)
#define PG8_LDA(dst, b, h) do { _Pragma("unroll") for (int m = 0; m < 4; ++m) _Pragma("unroll") for (int k = 0; k < 2; ++k) dst[m][k] = *(const PG8_LAS bf16x8*)(lds + PG8_SA(b, h) + aoff + m * 2048 + k * 1024); } while (0)
#define PG8_LDB(dst, b, h) do { _Pragma("unroll") for (int n = 0; n < 2; ++n) _Pragma("unroll") for (int k = 0; k < 2; ++k) dst[n][k] = *(const PG8_LAS bf16x8*)(lds + PG8_SB(b, h) + boff + n * 2048 + k * 1024); } while (0)
#define PG8_MMA(ai, bj, At, Bt) do { __builtin_amdgcn_s_setprio(1); _Pragma("unroll") for (int m = 0; m < 4; ++m) _Pragma("unroll") for (int n = 0; n < 2; ++n) _Pragma("unroll") for (int k = 0; k < 2; ++k) \
        acc[ai][bj][m][n] = __builtin_amdgcn_mfma_f32_16x16x32_bf16(Bt[n][k], At[m][k], acc[ai][bj][m][n], 0, 0, 0); __builtin_amdgcn_s_setprio(0); } while (0)
#define PG8_WAIT_V(n) asm volatile("s_waitcnt vmcnt(" #n ")" ::: "memory")
#define PG8_WAIT_L(n) asm volatile("s_waitcnt lgkmcnt(" #n ")" ::: "memory")
#define PG8_BAR __builtin_amdgcn_s_barrier()
#define PG8_SCHED __builtin_amdgcn_sched_barrier(0)
    Unit cur, nxt; int ui = 0;
    if (!S.next(0, cur)) return;
    f32x4 acc[2][2][4][2];
#pragma unroll
    for (int a = 0; a < 2; ++a)
#pragma unroll
        for (int b = 0; b < 2; ++b)
#pragma unroll
            for (int m = 0; m < 4; ++m)
#pragma unroll
                for (int n = 0; n < 2; ++n) acc[a][b][m][n] = (f32x4){0.f, 0.f, 0.f, 0.f};
    bf16x8 At[4][2], B0[2][2], B1[2][2];
    const char* cA = (const char*)g.A + (size_t)cur.pm * tstep; const char* cB = (const char*)g.Bt + (size_t)cur.pn * tstep;
    S.a_ready(cur);
    if constexpr (SP2) {
        PG8_STAGE(PG8_SB(0, 0), cB, voffB); PG8_STAGE(PG8_SB(0, 1), cB + hstep, voffB); PG8_STAGE(PG8_SA(0, 0), cA, voffA); PG8_STAGE(PG8_SA(0, 1), cA + hstep, voffA);
        if (wr == 1) PG8_BAR;
        PG8_WAIT_V(2); PG8_BAR;
        PG8_STAGE(PG8_SB(1, 0), cB + kstep, voffB); PG8_STAGE(PG8_SA(1, 0), cA + kstep, voffA); PG8_STAGE(PG8_SB(1, 1), cB + hstep + kstep, voffB);
        PG8_WAIT_V(6); PG8_BAR;
    } else {
        PG8_STAGE(PG8_SB(0, 0), cB, voffB); PG8_STAGE(PG8_SA(0, 0), cA, voffA); PG8_STAGE(PG8_SB(0, 1), cB + hstep, voffB); PG8_STAGE(PG8_SA(0, 1), cA + hstep, voffA);
        if (wr == 1) PG8_BAR;
        PG8_WAIT_V(4); PG8_BAR;
        PG8_STAGE(PG8_SB(1, 0), cB + kstep, voffB); PG8_STAGE(PG8_SA(1, 0), cA + kstep, voffA); PG8_STAGE(PG8_SB(1, 1), cB + hstep + kstep, voffB);
        PG8_WAIT_V(6); PG8_BAR;
    }
    for (;;) {
        const bool has_next = S.next(ui + 1, nxt);
        const char* nA = has_next ? (const char*)g.A + (size_t)nxt.pm * tstep : cA; const char* nB = has_next ? (const char*)g.Bt + (size_t)nxt.pn * tstep : cB;
        _Pragma("nounroll") for (int t = 0; t < nt; t += 2) {
            const bool last = (t == nt - 2);
            const char* a1 = cA + (size_t)(t + 1) * kstep;
            const char* a2 = last ? nA : cA + (size_t)(t + 2) * kstep; const char* b2 = last ? nB : cB + (size_t)(t + 2) * kstep;
            const char* a3 = a2 + kstep; const char* b3 = b2 + kstep;
            if (last && has_next) S.a_ready(nxt);
            if constexpr (SP2) {
            PG8_LDB(B0, 0, 0); PG8_LDB(B1, 0, 1); PG8_SCHED; PG8_LDA(At, 0, 0); PG8_STAGE(PG8_SA(1, 1), a1 + hstep, voffA);
            PG8_WAIT_V(8); PG8_WAIT_L(0); PG8_BAR; PG8_MMA(0, 0, At, B0); PG8_MMA(0, 1, At, B1); PG8_BAR; PG8_SCHED;
            PG8_LDA(At, 0, 1); PG8_STAGE(PG8_SB(0, 0), b2, voffB); PG8_STAGE(PG8_SB(0, 1), b2 + hstep, voffB); PG8_STAGE(PG8_SA(0, 0), a2, voffA);
            PG8_WAIT_V(8); PG8_WAIT_L(0); PG8_BAR; PG8_MMA(1, 0, At, B0); PG8_MMA(1, 1, At, B1); PG8_BAR; PG8_SCHED;
            PG8_LDB(B0, 1, 0); PG8_LDB(B1, 1, 1); PG8_SCHED; PG8_LDA(At, 1, 0); PG8_STAGE(PG8_SA(0, 1), a2 + hstep, voffA);
            PG8_WAIT_V(8); PG8_WAIT_L(0); PG8_BAR; PG8_MMA(0, 0, At, B0); PG8_MMA(0, 1, At, B1); PG8_BAR; PG8_SCHED;
            PG8_LDA(At, 1, 1); PG8_STAGE(PG8_SB(1, 0), b3, voffB); PG8_STAGE(PG8_SB(1, 1), b3 + hstep, voffB); PG8_STAGE(PG8_SA(1, 0), a3, voffA);
            PG8_WAIT_V(8); PG8_WAIT_L(0); PG8_BAR; PG8_MMA(1, 0, At, B0); PG8_MMA(1, 1, At, B1); PG8_BAR; PG8_SCHED;
            } else {
            PG8_LDB(B0, 0, 0); PG8_SCHED; PG8_LDA(At, 0, 0); PG8_STAGE(PG8_SA(1, 1), a1 + hstep, voffA);
            PG8_WAIT_L(8); PG8_BAR; PG8_WAIT_L(0); PG8_MMA(0, 0, At, B0); PG8_BAR; PG8_SCHED;
            PG8_LDB(B1, 0, 1); PG8_STAGE(PG8_SB(0, 0), b2, voffB);
            PG8_BAR; PG8_WAIT_L(0); PG8_MMA(0, 1, At, B1); PG8_BAR;
            PG8_LDA(At, 0, 1); PG8_STAGE(PG8_SA(0, 0), a2, voffA);
            PG8_BAR; PG8_WAIT_L(0); PG8_MMA(1, 0, At, B0); PG8_BAR; PG8_SCHED;
            PG8_STAGE(PG8_SB(0, 1), b2 + hstep, voffB);
            PG8_WAIT_V(6); PG8_BAR; PG8_MMA(1, 1, At, B1); PG8_BAR;
            PG8_LDB(B0, 1, 0); PG8_SCHED; PG8_LDA(At, 1, 0); PG8_STAGE(PG8_SA(0, 1), a2 + hstep, voffA);
            PG8_WAIT_L(8); PG8_BAR; PG8_WAIT_L(0); PG8_MMA(0, 0, At, B0); PG8_BAR; PG8_SCHED;
            PG8_LDB(B1, 1, 1); PG8_STAGE(PG8_SB(1, 0), b3, voffB);
            PG8_BAR; PG8_WAIT_L(0); PG8_MMA(0, 1, At, B1); PG8_BAR;
            PG8_LDA(At, 1, 1); PG8_STAGE(PG8_SA(1, 0), a3, voffA);
            PG8_BAR; PG8_WAIT_L(0); PG8_MMA(1, 0, At, B0); PG8_BAR; PG8_SCHED;
            PG8_STAGE(PG8_SB(1, 1), b3 + hstep, voffB);
            PG8_WAIT_V(6); PG8_BAR; PG8_MMA(1, 1, At, B1); PG8_BAR;
            }
        }
        if constexpr (ALIGN_EPI) { if (wr == 0) PG8_BAR; }
        if constexpr (!Epi::AFTER_DRAIN) { E(acc, cur, wr, wc, fr, fq); S.done(cur); }
        if (!has_next) break;
#pragma unroll
        for (int a = 0; a < 2; ++a)
#pragma unroll
            for (int b = 0; b < 2; ++b)
#pragma unroll
                for (int m = 0; m < 4; ++m)
#pragma unroll
                    for (int n = 0; n < 2; ++n) acc[a][b][m][n] = (f32x4){0.f, 0.f, 0.f, 0.f};
        cur = nxt; cA = nA; cB = nB; ++ui;
        if constexpr (ALIGN_EPI) { if (wr == 1) PG8_BAR; }
    }
    PG8_WAIT_V(0);
    if constexpr (!ALIGN_EPI) { if (wr == 0) PG8_BAR; }
    PG8_BAR;
    if constexpr (Epi::AFTER_DRAIN) { E.fused(acc, cur, wr, wc, fr, fq, lds, wid, lane); S.done(cur); }
#undef PG8_SA
#undef PG8_SB
#undef PG8_STAGE
#undef PG8_LDA
#undef PG8_LDB
#undef PG8_MMA
#undef PG8_WAIT_V
#undef PG8_WAIT_L
#undef PG8_BAR
#undef PG8_SCHED
}
}
#define GAS __attribute__((address_space(1)))
#define LAS __attribute__((address_space(3)))
typedef unsigned short bf16;
typedef unsigned v4u __attribute__((ext_vector_type(4)));
typedef float f32x4 __attribute__((ext_vector_type(4)));
typedef short bf16x8 __attribute__((ext_vector_type(8)));
typedef GAS unsigned gu32;
typedef GAS unsigned long long gu64;
#define RLX_AGENT __ATOMIC_RELAXED, __HIP_MEMORY_SCOPE_AGENT
#define LDS_WAIT() asm volatile("s_waitcnt lgkmcnt(0)" ::: "memory")
#define VM_WAIT() asm volatile("s_waitcnt vmcnt(0)" ::: "memory")
__device__ __forceinline__ unsigned long long rt() { return __builtin_amdgcn_s_memrealtime(); }
__device__ __forceinline__ unsigned f2bf(float f) { unsigned u = __builtin_bit_cast(unsigned, f); return (u + 0x7fffu + ((u >> 16) & 1u)) >> 16; }
__device__ __forceinline__ unsigned pk2(float lo, float hi) { return f2bf(lo) | (f2bf(hi) << 16); }

#define XB_TMO      128
#define XB_XCNT(j)  (256  + 64 * (j))
#define XB_XSUB(j)  (1280 + 64 * (j))
#define XB_XGEN(j)  (2304 + 64 * (j))
#define XB_TOP      3328
#define XB_TOPGEN   3392
#define XCD_BAR_WORDS 3456
#define XB_SPIN_CAP (1u << 18)

__device__ __forceinline__ unsigned xb_ld(unsigned* p)              { return __hip_atomic_load(p, __ATOMIC_RELAXED, __HIP_MEMORY_SCOPE_AGENT); }
__device__ __forceinline__ unsigned xb_add(unsigned* p, unsigned v) { return __hip_atomic_fetch_add(p, v, __ATOMIC_RELAXED, __HIP_MEMORY_SCOPE_AGENT); }
__device__ __forceinline__ unsigned xb_xcc_id() { return (unsigned)__builtin_amdgcn_s_getreg((3 << 11) | 20) & 0xFu; }
#define XB_SPIN(cond, bar) do { unsigned _sp = 0; while (cond) { __builtin_amdgcn_s_sleep(1); \
    if ((++_sp & 255u) == 0u) { if (xb_ld(&(bar)[XB_TMO])) break; if (_sp > XB_SPIN_CAP) { atomicAdd(&(bar)[XB_TMO], 1u); break; } } } } while (0)

struct XcdBarrier {
    unsigned* bar; unsigned x;
    volatile LAS unsigned* st;
};

__device__ __forceinline__ XcdBarrier xcd_barrier_post(unsigned* bar, volatile LAS unsigned* st) {
    XcdBarrier b; b.bar = bar; b.x = xb_xcc_id(); b.st = st;
    if (threadIdx.x == 0) (void)xb_add(&bar[XB_XCNT(b.x)], 1u);
    return b;
}
__device__ __forceinline__ void xcd_barrier_complete(unsigned* bar, unsigned x, unsigned& nloc, unsigned& nx) {
    const unsigned G = gridDim.x * gridDim.y * gridDim.z;
    unsigned sum, cnt, mine, sp = 0u;
    for (;;) {
        sum = 0u; cnt = 0u; mine = 0u;
#pragma unroll
        for (unsigned j = 0; j < 16; ++j) { const unsigned c = xb_ld(&bar[XB_XCNT(j)]); sum += c; cnt += (c > 0u) ? 1u : 0u; mine = (j == x) ? c : mine; }
        if (sum == G) break;
        __builtin_amdgcn_s_sleep(1);
        if ((++sp & 255u) == 0u) { if (xb_ld(&bar[XB_TMO])) break; if (sp > XB_SPIN_CAP) { atomicAdd(&bar[XB_TMO], 1u); break; } }
    }
    nloc = mine > 0u ? mine : 1u; nx = cnt > 0u ? cnt : 1u;
}

__device__ __forceinline__ void xcd_barrier(const XcdBarrier& b) {
    asm volatile("s_waitcnt vmcnt(0)" ::: "memory");
    __syncthreads();
    if (threadIdx.x == 0) {
        unsigned* bar = b.bar;
        __builtin_amdgcn_s_waitcnt(0);
        unsigned nloc = b.st[0], nx = b.st[1];
        if (nloc == 0u) { xcd_barrier_complete(bar, b.x, nloc, nx); b.st[0] = nloc; b.st[1] = nx; }
        const unsigned old = xb_add(&bar[XB_XSUB(b.x)], 1u);
        const unsigned gen = old / nloc;
        if (old + 1u == (gen + 1u) * nloc) {
            __builtin_amdgcn_fence(__ATOMIC_RELEASE, "agent");
            asm volatile("s_waitcnt vmcnt(0)" ::: "memory");
            const unsigned og = xb_add(&bar[XB_TOP], 1u);
            const unsigned tg = og / nx;
            if (og + 1u == (tg + 1u) * nx) xb_add(&bar[XB_TOPGEN], 1u);
            else XB_SPIN(xb_ld(&bar[XB_TOPGEN]) == tg, bar);
            __builtin_amdgcn_fence(__ATOMIC_ACQUIRE, "agent");
            xb_add(&bar[XB_XGEN(b.x)], 1u);
            asm volatile("s_waitcnt vmcnt(0)" ::: "memory");
        } else {
            XB_SPIN(xb_ld(&bar[XB_XGEN(b.x)]) == gen, bar);
            __builtin_amdgcn_fence(__ATOMIC_ACQUIRE, "agent");
            asm volatile("s_waitcnt vmcnt(0)" ::: "memory");
        }
    }
    __syncthreads();
}
using pg8::bf_lo; using pg8::bf_hi;

constexpr int NWAVES = 8;
constexpr int M = 32768, D = 1024, SEQ = 4096, DEPTH = 4, PLE = 256;
constexpr float EPS = 1e-6f;
#ifndef EN_MASK
#define EN_MASK 0xff
#endif
#ifndef MK_MULTI
#define MK_MULTI 0
#endif
constexpr size_t MiB = 1u << 20;
constexpr size_t WS_CTL = 0, CTL_ZERO_BYTES = 1 * MiB;
constexpr size_t WS_WAIN = 2 * MiB;
constexpr size_t WS_WAOUT = 18 * MiB;
constexpr size_t WS_WBIN = 22 * MiB;
constexpr size_t WS_WBOUT = 30 * MiB;
constexpr size_t WS_WG = 34 * MiB;
constexpr size_t WS_WP = 42 * MiB;
constexpr size_t WS_SSQA = 44 * MiB, WS_SSQB = 46 * MiB;
constexpr size_t WS_PB = 48 * MiB;
constexpr size_t WS_HB0 = 64 * MiB, WS_HB1 = 128 * MiB, WS_G = 192 * MiB, WS_PROJ = 256 * MiB, WS_END = 512 * MiB;
constexpr int CW_BAR = 4096;
constexpr int RING_OFF = 0, RING_BYTES = 131072;
constexpr int LDSCTL_OFF = RING_BYTES, MISC_OFF = LDSCTL_OFF + 320;
constexpr int LDS_BYTES = 147456;

struct Frame {
    LAS unsigned char* lds;
    volatile LAS unsigned* MISC;
    int tid, lane, wave, vcu, G;
};
__device__ __forceinline__ float wave_sum(float v) {
#pragma unroll
    for (int o = 1; o < 64; o <<= 1) v += __shfl_xor(v, o);
    return v;
}
typedef unsigned v2u __attribute__((ext_vector_type(2)));
__device__ __forceinline__ unsigned pk_bf16(float lo, float hi) { return pg8::cvt_pk_bf16(lo, hi); }

template <int MAP> __device__ __forceinline__ int rowmap(int n) {
    if (MAP == 1) { const int type = n >> 10, e = n & 1023; return 256 * (e >> 6) + 128 * (type >> 1) + 32 * ((e & 63) >> 4) + 8 * ((e >> 2) & 3) + 4 * (type & 1) + (e & 3); }
    if (MAP == 2) { return 256 * (n >> 7) + 128 + (n & 127); }
    return n;
}
template <int MAP>
__device__ __forceinline__ void transpose_item(const float* W, int ldw, int ncols, int K, const float* gk, bf16* WT, LAS float* scr, int item, int lane) {
    const int nblk = ncols / 32, kb = item / nblk, nb = item % nblk, k0 = 64 * kb, n0 = 32 * nb;
#pragma unroll 8
    for (int i = 0; i < 32; ++i) { const int kk = 2 * i + (lane >> 5); float v = W[(size_t)(k0 + kk) * ldw + n0 + (lane & 31)]; if (gk) v *= gk[k0 + kk]; scr[kk * 33 + (lane & 31)] = v; }
    LDS_WAIT(); asm volatile("" ::: "memory");
    const int c = lane & 7;
#pragma unroll
    for (int j = 0; j < 4; ++j) { const int n = (lane >> 3) + 8 * j; const LAS float* s = scr + (8 * c) * 33 + n;
        v4u o; o.x = pk_bf16(s[0 * 33], s[1 * 33]); o.y = pk_bf16(s[2 * 33], s[3 * 33]); o.z = pk_bf16(s[4 * 33], s[5 * 33]); o.w = pk_bf16(s[6 * 33], s[7 * 33]);
        *(GAS v4u*)(WT + (size_t)rowmap<MAP>(n0 + n) * K + k0 + 8 * c) = o; }
    LDS_WAIT(); asm volatile("" ::: "memory");
}
typedef float f32x16 __attribute__((ext_vector_type(16)));
__device__ __forceinline__ void fold_item(const float* win  , const float* wgrp  , const float* nm, bf16* WT, int item, int lane) {
    const int g = item >> 8, kt = (item >> 3) & 31, dt = item & 7, k0 = 32 * kt, d0 = 32 * dt, h = lane >> 5, l31 = lane & 31;
    f32x16 acc;
#pragma unroll
    for (int q = 0; q < 16; ++q) acc[q] = 0.f;
    const float* arow = win + (size_t)(k0 + l31) * 2048 + g * 256 + 4 * h;
    const float* bcol = wgrp + (size_t)g * 65536 + (size_t)(4 * h) * 256 + d0 + l31;
#pragma unroll 4
    for (int c0 = 0; c0 < 256; c0 += 8) {
        const f32x4 a = *(const f32x4*)(arow + c0);
#pragma unroll
        for (int j = 0; j < 4; ++j) { const float b = bcol[(size_t)(c0 + j) * 256]; acc = __builtin_amdgcn_mfma_f32_32x32x2f32(a[j], b, acc, 0, 0, 0); }
    }
    const int e = g * 256 + d0 + l31; bf16* orow = WT + (size_t)(256 * (e >> 7) + (e & 127)) * 1024 + k0 + 4 * h;
#pragma unroll
    for (int qq = 0; qq < 4; ++qq) { const int kb = k0 + 8 * qq + 4 * h; const f32x4 gn = *(const f32x4*)(nm + kb);
        v2u o; o.x = pk_bf16(acc[4 * qq + 0] * gn[0], acc[4 * qq + 1] * gn[1]); o.y = pk_bf16(acc[4 * qq + 2] * gn[2], acc[4 * qq + 3] * gn[3]);
        *(GAS v2u*)(orow + 8 * qq) = o; }
}
__device__ __forceinline__ void x_row(const float* xrow, bf16* orow, float* ssq, int lane) {
    const GAS f32x4* xr = (const GAS f32x4*)xrow + lane;
    f32x4 v[4]; float s = 0.f;
#pragma unroll
    for (int j = 0; j < 4; ++j) { v[j] = xr[64 * j]; s += (v[j][0] * v[j][0] + v[j][1] * v[j][1]) + (v[j][2] * v[j][2] + v[j][3] * v[j][3]); }
    s = wave_sum(s);
    GAS v2u* o8 = (GAS v2u*)orow + lane;
#pragma unroll
    for (int j = 0; j < 4; ++j) { v2u o; o.x = pk_bf16(v[j][0], v[j][1]); o.y = pk_bf16(v[j][2], v[j][3]); o8[64 * j] = o; }
    if (lane < 16) ssq[lane] = lane == 0 ? s : 0.f;
}
__device__ __forceinline__ void convert_p(const Frame& F, const float* p, bf16* pb) {
    const size_t n8 = (size_t)M * PLE / 8, stride = (size_t)F.G * NWAVES * 64;
    for (size_t i = (size_t)(F.vcu * NWAVES + F.wave) * 64 + F.lane; i < n8; i += stride) {
        const f32x4 a = *(const GAS f32x4*)(p + 8 * i), b = *(const GAS f32x4*)(p + 8 * i + 4);
        v4u o; o.x = pk_bf16(a[0], a[1]); o.y = pk_bf16(a[2], a[3]); o.z = pk_bf16(b[0], b[1]); o.w = pk_bf16(b[2], b[3]);
        *(GAS v4u*)(pb + 8 * i) = o; }
}
__device__ __forceinline__ float silu_f(float z) { return z * pg8::sigmoidf_fast(z); }

struct Args { const float* in[14]; float* out; unsigned char* ws; int ph_lo, ph_hi; };
constexpr int NPH = 2 + 4 * DEPTH;

__global__ void __launch_bounds__(NWAVES * 64, 2) mk_fwd(Args args) {
    extern __shared__ __attribute__((aligned(16))) unsigned char lds_raw[];
    Frame F;
    F.lds = (LAS unsigned char*)lds_raw;
    F.MISC = (volatile LAS unsigned*)(F.lds + MISC_OFF);
    F.tid = threadIdx.x; F.lane = F.tid & 63; F.wave = __builtin_amdgcn_readfirstlane(F.tid >> 6);
    F.G = gridDim.x; { const int bx = blockIdx.x; F.vcu = (F.G % 8 == 0) ? (bx % 8) * (F.G / 8) + bx / 8 : bx; }
    unsigned char* ws = args.ws;
    const float* x = args.in[0]; const float* p = args.in[1]; const float* norm_mix = args.in[2]; const float* a_w_in = args.in[3]; const float* a_w_conv = args.in[4];
    const float* a_w_out = args.in[5]; const float* b_w_in = args.in[6]; const float* b_w_grp = args.in[7]; const float* b_scale = args.in[8]; const float* b_w_out = args.in[9];
    const float* ple_norm = args.in[10]; const float* ple_w_gate = args.in[11]; const float* ple_w_proj = args.in[12]; const float* final_norm = args.in[13];
    float* out = args.out;
    bf16* WAin = (bf16*)(ws + WS_WAIN); bf16* WAout = (bf16*)(ws + WS_WAOUT); bf16* WBin = (bf16*)(ws + WS_WBIN); bf16* WBout = (bf16*)(ws + WS_WBOUT);
    bf16* WG = (bf16*)(ws + WS_WG); bf16* WP = (bf16*)(ws + WS_WP); float* SSQA = (float*)(ws + WS_SSQA); float* SSQB = (float*)(ws + WS_SSQB);
    bf16* PB = (bf16*)(ws + WS_PB); bf16* HB0 = (bf16*)(ws + WS_HB0); bf16* HB1 = (bf16*)(ws + WS_HB1); bf16* GB = (bf16*)(ws + WS_G); bf16* PROJ = (bf16*)(ws + WS_PROJ);

    for (int u = F.tid; u < (LDS_BYTES - LDSCTL_OFF) / 4; u += NWAVES * 64) ((LAS unsigned*)(F.lds + LDSCTL_OFF))[u] = 0u;
    __syncthreads();
    XcdBarrier bar; bar.bar = (unsigned*)(ws + WS_CTL) + CW_BAR; bar.x = 0; bar.st = nullptr;
    if (!MK_MULTI) bar = xcd_barrier_post((unsigned*)(ws + WS_CTL) + CW_BAR, F.MISC + 8);

    for (int ph = args.ph_lo; ph < args.ph_hi; ++ph) {
        { int t_ = threadIdx.x; asm volatile("" : "+v"(t_)); F.tid = t_; F.lane = t_ & 63; F.wave = __builtin_amdgcn_readfirstlane(t_ >> 6); }
        const int gw = F.vcu * NWAVES + F.wave, NGW = F.G * NWAVES;
        if (ph == 0) {
#if EN_MASK & 1
            LAS float* scr = (LAS float*)(F.lds + RING_OFF + F.wave * 16384);
            constexpr int I_AIN = 16 * 128, I_SQ = 16 * 32, I_WP = 4 * 32, I_FOLD = 1024;
            constexpr int N_AIN = 2 * I_AIN, N_AOUT = 2 * I_SQ, N_BZ = 2 * I_SQ, N_BOUT = 2 * I_SQ, N_WG = 4 * I_SQ, N_WP = 4 * I_WP, N_FOLD = 2 * I_FOLD;
            constexpr int NITEMS = N_FOLD + N_AIN + N_AOUT + N_BZ + N_BOUT + N_WG + N_WP;
            for (int it = gw; it < NITEMS; it += NGW) {
                int r = it;
                if (r < N_FOLD) { const int j = r / I_FOLD; fold_item(b_w_in + (size_t)j * 1024 * 2048, b_w_grp + (size_t)j * 4 * 65536, norm_mix + (2 * j + 1) * 1024, WBin + (size_t)j * 2048 * 1024, r % I_FOLD, F.lane); continue; } r -= N_FOLD;
                if (r < N_AIN) { const int j = r / I_AIN; transpose_item<1>(a_w_in + (size_t)j * 1024 * 4096, 4096, 4096, 1024, norm_mix + (2 * j) * 1024, WAin + (size_t)j * 4096 * 1024, scr, r % I_AIN, F.lane); continue; } r -= N_AIN;
                if (r < N_AOUT) { const int j = r / I_SQ; transpose_item<0>(a_w_out + (size_t)j * 1024 * 1024, 1024, 1024, 1024, nullptr, WAout + (size_t)j * 1024 * 1024, scr, r % I_SQ, F.lane); continue; } r -= N_AOUT;
                if (r < N_BZ) { const int j = r / I_SQ; transpose_item<2>(b_w_in + (size_t)j * 1024 * 2048 + 1024, 2048, 1024, 1024, norm_mix + (2 * j + 1) * 1024, WBin + (size_t)j * 2048 * 1024, scr, r % I_SQ, F.lane); continue; } r -= N_BZ;
                if (r < N_BOUT) { const int j = r / I_SQ; transpose_item<0>(b_w_out + (size_t)j * 1024 * 1024, 1024, 1024, 1024, nullptr, WBout + (size_t)j * 1024 * 1024, scr, r % I_SQ, F.lane); continue; } r -= N_BOUT;
                if (r < N_WG) { const int j = r / I_SQ; transpose_item<0>(ple_w_gate + (size_t)j * 1024 * 1024, 1024, 1024, 1024, ple_norm + j * 1024, WG + (size_t)j * 1024 * 1024, scr, r % I_SQ, F.lane); continue; } r -= N_WG;
                { const int j = r / I_WP; transpose_item<0>(ple_w_proj + (size_t)j * 256 * 1024, 1024, 1024, 256, nullptr, WP + (size_t)j * 1024 * 256, scr, r % I_WP, F.lane); }
            }
            for (int m = gw; m < M; m += NGW) x_row(x + (size_t)m * D, HB0 + (size_t)m * D, SSQB + (size_t)m * 16, F.lane);
            convert_p(F, p, PB);
#endif
        } else if (ph == NPH - 1) {
#if EN_MASK & 64
            for (int m = gw; m < M; m += NGW) {
                const float rs = pg8::row_rs(SSQB, m);
                GAS f32x4* hr = (GAS f32x4*)(out + (size_t)m * D) + F.lane;
#pragma unroll
                for (int j = 0; j < 4; ++j) { const f32x4 g = *((const GAS f32x4*)final_norm + F.lane + 64 * j); hr[64 * j] = hr[64 * j] * rs * g; }
            }
#endif
        } else {
            const int i = (ph - 1) >> 2, s = (ph - 1) & 3, j = i >> 1; const bool isA = (i & 1) == 0;
            if (s == 0) {
#if EN_MASK & 2
                const int N = isA ? 4096 : 2048;
                pg8::Gemm g{HB0, isA ? WAin + (size_t)j * 4096 * 1024 : WBin + (size_t)j * 2048 * 1024, M, N, D}; pg8::StaticOrder S; S.init(M, N, F.G, (int)blockIdx.x);
                pg8::EpiProj E{PROJ, N, SSQB};
                pg8::gemm_phase<pg8::EpiProj, pg8::StaticOrder, true, true>(F.lds + RING_OFF, g, S, E);
#endif
            } else if (s == 1) {
#if EN_MASK & 4
                const size_t gt = (size_t)blockIdx.x * (NWAVES * 64) + F.tid, GT = (size_t)F.G * NWAVES * 64;
                if (isA) {
                    const float* wc0 = a_w_conv + (size_t)j * 3 * 1024;
                    for (size_t idx = gt; idx < (size_t)M * 256; idx += GT) {
                        const int t = (int)(idx >> 8), q = (int)(idx & 255), tt = t & (SEQ - 1);
                        const int colb = 256 * (q >> 4) + 32 * ((q & 15) >> 2) + 8 * (q & 3);
                        const bf16* pr = PROJ + (size_t)t * 4096 + colb;
                        const v2u bw = *(const GAS v2u*)pr, cw = *(const GAS v2u*)(pr + 4), vw = *(const GAS v2u*)(pr + 128), zw = *(const GAS v2u*)(pr + 132);
                        v2u c1 = {0u, 0u}, v1 = c1, c2 = c1, v2 = c1;
                        if (tt >= 1) { c1 = *(const GAS v2u*)(pr - 4096 + 4); v1 = *(const GAS v2u*)(pr - 4096 + 128); }
                        if (tt >= 2) { c2 = *(const GAS v2u*)(pr - 8192 + 4); v2 = *(const GAS v2u*)(pr - 8192 + 128); }
                        const f32x4 w0 = *(const GAS f32x4*)(wc0 + 4 * q), w1 = *(const GAS f32x4*)(wc0 + 1024 + 4 * q), w2 = *(const GAS f32x4*)(wc0 + 2048 + 4 * q);
                        float o[4];
                        const float bb[4] = {bf_lo(bw.x), bf_hi(bw.x), bf_lo(bw.y), bf_hi(bw.y)}, zz[4] = {bf_lo(zw.x), bf_hi(zw.x), bf_lo(zw.y), bf_hi(zw.y)};
                        const float cv0[4] = {bf_lo(cw.x) * bf_lo(vw.x), bf_hi(cw.x) * bf_hi(vw.x), bf_lo(cw.y) * bf_lo(vw.y), bf_hi(cw.y) * bf_hi(vw.y)};
                        const float cv1[4] = {bf_lo(c1.x) * bf_lo(v1.x), bf_hi(c1.x) * bf_hi(v1.x), bf_lo(c1.y) * bf_lo(v1.y), bf_hi(c1.y) * bf_hi(v1.y)};
                        const float cv2[4] = {bf_lo(c2.x) * bf_lo(v2.x), bf_hi(c2.x) * bf_hi(v2.x), bf_lo(c2.y) * bf_lo(v2.y), bf_hi(c2.y) * bf_hi(v2.y)};
#pragma unroll
                        for (int e = 0; e < 4; ++e) o[e] = silu_f(zz[e]) * bb[e] * (w0[e] * cv2[e] + w1[e] * cv1[e] + w2[e] * cv0[e]);
                        v2u ow; ow.x = pk_bf16(o[0], o[1]); ow.y = pk_bf16(o[2], o[3]);
                        *(GAS v2u*)(GB + (size_t)t * 1024 + 4 * q) = ow;
                    }
                } else {
                    const float* sc = b_scale + (size_t)j * 1024;
                    for (size_t idx = gt; idx < (size_t)M * 128; idx += GT) {
                        const int t = (int)(idx >> 7), q = (int)(idx & 127), tt = t & (SEQ - 1);
                        const int col = 256 * (q >> 4) + 8 * (q & 15), w = 2 << (q >> 5), cnt = (tt + 1) < w ? (tt + 1) : w;
                        const bf16* pr = PROJ + (size_t)t * 2048 + col;
                        const v4u uw = *(const GAS v4u*)pr, zw = *(const GAS v4u*)(pr + 128);
                        float sum[8] = {bf_lo(uw.x), bf_hi(uw.x), bf_lo(uw.y), bf_hi(uw.y), bf_lo(uw.z), bf_hi(uw.z), bf_lo(uw.w), bf_hi(uw.w)}, u0[8];
#pragma unroll
                        for (int e = 0; e < 8; ++e) u0[e] = sum[e];
                        for (int k = 1; k < cnt; ++k) { const v4u a = *(const GAS v4u*)(pr - (size_t)k * 2048);
                            sum[0] += bf_lo(a.x); sum[1] += bf_hi(a.x); sum[2] += bf_lo(a.y); sum[3] += bf_hi(a.y); sum[4] += bf_lo(a.z); sum[5] += bf_hi(a.z); sum[6] += bf_lo(a.w); sum[7] += bf_hi(a.w); }
                        const float inv = 1.0f / (float)cnt;
                        const float zz[8] = {bf_lo(zw.x), bf_hi(zw.x), bf_lo(zw.y), bf_hi(zw.y), bf_lo(zw.z), bf_hi(zw.z), bf_lo(zw.w), bf_hi(zw.w)};
                        const f32x4 s0 = *(const GAS f32x4*)(sc + 8 * q), s1 = *(const GAS f32x4*)(sc + 8 * q + 4);
                        float o[8];
#pragma unroll
                        for (int e = 0; e < 8; ++e) o[e] = silu_f(zz[e]) * (sum[e] * inv - u0[e]) * (e < 4 ? s0[e] : s1[e - 4]);
                        v4u ow; ow.x = pk_bf16(o[0], o[1]); ow.y = pk_bf16(o[2], o[3]); ow.z = pk_bf16(o[4], o[5]); ow.w = pk_bf16(o[6], o[7]);
                        *(GAS v4u*)(GB + (size_t)t * 1024 + 8 * q) = ow;
                    }
                }
                if (i > 0) convert_p(F, p + (size_t)i * M * PLE, PB);
#endif
            } else if (s == 2) {
#if EN_MASK & 8
                { pg8::Gemm g{GB, isA ? WAout + (size_t)j * 1024 * 1024 : WBout + (size_t)j * 1024 * 1024, M, D, D}; pg8::StaticOrder S; S.init(M, D, F.G, (int)blockIdx.x);
                  pg8::EpiResid E{i == 0 ? x : out, out, HB1, SSQA};
                  pg8::gemm_phase<pg8::EpiResid, pg8::StaticOrder, true, true>(F.lds + RING_OFF, g, S, E); }
#endif
#if EN_MASK & 16
                { pg8::Gemm g{PB, WP + (size_t)i * 1024 * 256, M, D, PLE}; pg8::StaticOrder S; S.init(M, D, F.G, (int)blockIdx.x);
                  pg8::EpiPlain E{PROJ, D};
                  pg8::gemm_phase<pg8::EpiPlain, pg8::StaticOrder, true, true>(F.lds + RING_OFF, g, S, E); }
#endif
            } else {
#if EN_MASK & 32
                pg8::Gemm g{HB1, WG + (size_t)i * 1024 * 1024, M, D, D}; pg8::StaticOrder S; S.init(M, D, F.G, (int)blockIdx.x);
                pg8::EpiPle E{out, out, HB0, PROJ, SSQA, SSQB};
                pg8::gemm_phase<pg8::EpiPle, pg8::StaticOrder, true, true>(F.lds + RING_OFF, g, S, E);
#endif
            }
        }
        if (ph + 1 < args.ph_hi) xcd_barrier(bar);
    }
}

extern "C" void kernel_launch(void* const* d_in, const int* in_sizes, int n_in, void* d_out, int out_size, void* d_ws, size_t ws_size, hipStream_t stream) {
    static int grid = 0;
    if (grid == 0) {
        if (n_in != 14 || in_sizes[0] != M * D || out_size != M * D || ws_size < WS_END) { fprintf(stderr, "kernel_launch: unexpected shapes (n_in %d, in0 %d, out %d, ws %zu); nothing launched\n", n_in, n_in > 0 ? in_sizes[0] : -1, out_size, ws_size); grid = -1; return; }
        int dev = 0, cus = 0, per_cu = 0;
        if (hipGetDevice(&dev) != hipSuccess || hipDeviceGetAttribute(&cus, hipDeviceAttributeMultiprocessorCount, dev) != hipSuccess) { grid = -1; return; }
        if (hipFuncSetAttribute((const void*)mk_fwd, hipFuncAttributeMaxDynamicSharedMemorySize, LDS_BYTES) != hipSuccess) { fprintf(stderr, "kernel_launch: hipFuncSetAttribute failed\n"); grid = -1; return; }
        if (hipOccupancyMaxActiveBlocksPerMultiprocessor(&per_cu, (const void*)mk_fwd, NWAVES * 64, LDS_BYTES) != hipSuccess || per_cu < 1) { fprintf(stderr, "kernel_launch: occupancy query says %d blocks per CU\n", per_cu); per_cu = 1; }
        (void)hipGetLastError();
        grid = cus;
    }
    if (grid < 0) return;
    (void)hipMemsetAsync((char*)d_ws + WS_CTL, 0, CTL_ZERO_BYTES, stream);
    Args a{};
    for (int i = 0; i < 14; ++i) a.in[i] = (const float*)d_in[i];
    a.out = (float*)d_out; a.ws = (unsigned char*)d_ws;
#if MK_MULTI
    for (int ph = 0; ph < NPH; ++ph) { a.ph_lo = ph; a.ph_hi = ph + 1; hipLaunchKernelGGL(mk_fwd, dim3(grid), dim3(NWAVES * 64), LDS_BYTES, stream, a); }
#else
    a.ph_lo = 0; a.ph_hi = NPH;
    hipLaunchKernelGGL(mk_fwd, dim3(grid), dim3(NWAVES * 64), LDS_BYTES, stream, a);
#endif
}
```

```cpp
#include <hip/hip_runtime.h>
#include <cstdio>
#include <cstdint>
namespace pg8 {
#define PG8_LAS __attribute__((address_space(3)))
typedef unsigned short bf16_t;
typedef short bf16x8 __attribute__((ext_vector_type(8)));
typedef float f32x4 __attribute__((ext_vector_type(4)));
typedef unsigned u32x4 __attribute__((ext_vector_type(4)));
constexpr int BM = 256, BK = 64, HALF = 128, HTB = HALF * BK * 2  , STAGE_BYTES = 8 * HTB, NXCD = 8, WGM = 8;

__host__ __device__ __forceinline__ int lds_byte(int r, int c) { const int st = (r >> 4) * 2 + (c >> 5), rr = r & 15, cc = c & 31, ob = rr * 64 + cc * 2; return st * 1024 + (ob ^ (((ob >> 9) & 1) << 5)); }
__host__ __device__ __forceinline__ void stage_rc(int b, int& R, int& C) { const int st = b / 1024, sb = b % 1024, swz = sb ^ (((sb >> 9) & 1) << 5); R = (st >> 1) * 16 + swz / 64; C = (st & 1) * 32 + (swz % 64) / 2; }
__host__ __device__ __forceinline__ int perm32(int rho) { const int n = rho >> 4, i = rho & 15; return 8 * (i >> 2) + 4 * n + (i & 3); }

struct Unit { int pm, pn; };
struct Gemm { const bf16_t* A; const bf16_t* Bt; int M, N, K; };

struct StaticOrder {
    int nM, nN, nwg, G, c;
    __host__ __device__ void init(int M, int N, int G_, int c_) { nM = M / BM; nN = N / BM; nwg = nM * nN; G = G_; c = c_; }
    __host__ __device__ bool next(int i, Unit& u) const {
        const long L = (long)i * G + c; if (L >= nwg) return false;
        int wgid = (int)L; { const int q = nwg / NXCD, r = nwg % NXCD, xcd = wgid % NXCD, off = wgid / NXCD; wgid = (xcd < r ? xcd * (q + 1) : r * (q + 1) + (xcd - r) * q) + off; }
        const int nig = WGM * nN, gid = wgid / nig, fm = gid * WGM, gsz = (nM - fm) < WGM ? (nM - fm) : WGM;
        u.pm = fm + ((wgid % nig) % gsz); u.pn = (wgid % nig) / gsz; return true;
    }
    __device__ __forceinline__ void a_ready(const Unit&) const {}
    __device__ __forceinline__ void done(const Unit&) const {}
};

__device__ __forceinline__ unsigned cvt_pk_bf16(float lo, float hi) { unsigned r; asm volatile("v_cvt_pk_bf16_f32 %0, %1, %2" : "=v"(r) : "v"(lo), "v"(hi)); return r; }
__device__ __forceinline__ float bf_lo(unsigned w) { return __builtin_bit_cast(float, w << 16); }
__device__ __forceinline__ float bf_hi(unsigned w) { return __builtin_bit_cast(float, w & 0xffff0000u); }
__device__ __forceinline__ float sigmoidf_fast(float x) { return __builtin_amdgcn_rcpf(1.0f + __builtin_amdgcn_exp2f(x * -1.44269504089f)); }
__device__ __forceinline__ float row_rs(const float* ssq, int row) {
    const f32x4* p = (const f32x4*)(ssq + (size_t)row * 16);
    const f32x4 a = p[0], b = p[1], c = p[2], d = p[3];
    const f32x4 s = (a + b) + (c + d);
    return __builtin_amdgcn_rsqf(((s[0] + s[1]) + (s[2] + s[3])) * (1.0f / 1024.0f) + 1e-6f);
}

struct EpiPlain {
    static constexpr bool PERM = true, AFTER_DRAIN = false;
    bf16_t* O; int ldc;
    __device__ __forceinline__ void operator()(const f32x4 (&acc)[2][2][4][2], const Unit& u, int wr, int wc, int fr, int fq) const {
        const int row0 = u.pm * BM + wr * 64 + fr, col0 = u.pn * BM + wc * 32 + 8 * fq;
#pragma unroll
        for (int ai = 0; ai < 2; ++ai)
#pragma unroll
            for (int m = 0; m < 4; ++m) { bf16_t* rowp = O + (size_t)(row0 + ai * HALF + m * 16) * ldc + col0;
#pragma unroll
                for (int bj = 0; bj < 2; ++bj) { const f32x4 v0 = acc[ai][bj][m][0], v1 = acc[ai][bj][m][1];
                    u32x4 w; w.x = cvt_pk_bf16(v0[0], v0[1]); w.y = cvt_pk_bf16(v0[2], v0[3]); w.z = cvt_pk_bf16(v1[0], v1[1]); w.w = cvt_pk_bf16(v1[2], v1[3]);
                    *(u32x4*)(rowp + bj * HALF) = w; } }
    }
};
struct EpiProj {
    static constexpr bool PERM = true, AFTER_DRAIN = false;
    bf16_t* O; int ldc; const float* ssq;
    __device__ __forceinline__ void operator()(const f32x4 (&acc)[2][2][4][2], const Unit& u, int wr, int wc, int fr, int fq) const {
        const int row0 = u.pm * BM + wr * 64 + fr, col0 = u.pn * BM + wc * 32 + 8 * fq;
#pragma unroll
        for (int ai = 0; ai < 2; ++ai)
#pragma unroll
            for (int m = 0; m < 4; ++m) { const int row = row0 + ai * HALF + m * 16; const float rs = row_rs(ssq, row); bf16_t* rowp = O + (size_t)row * ldc + col0;
#pragma unroll
                for (int bj = 0; bj < 2; ++bj) { const f32x4 v0 = acc[ai][bj][m][0] * rs, v1 = acc[ai][bj][m][1] * rs;
                    u32x4 w; w.x = cvt_pk_bf16(v0[0], v0[1]); w.y = cvt_pk_bf16(v0[2], v0[3]); w.z = cvt_pk_bf16(v1[0], v1[1]); w.w = cvt_pk_bf16(v1[2], v1[3]);
                    *(u32x4*)(rowp + bj * HALF) = w; } }
    }
};
template <int CTRL> __device__ __forceinline__ float dpp_mov(float old, float src) {
    return __builtin_bit_cast(float, __builtin_amdgcn_update_dpp(__builtin_bit_cast(int, old), __builtin_bit_cast(int, src), CTRL, 0xf, 0xf, false)); }
constexpr int DPP_SHR = 0x110, DPP_ROR = 0x120;
template <int S> __device__ __forceinline__ float row_up(float cur, float prev) { return dpp_mov<DPP_SHR + S>(dpp_mov<DPP_ROR + S>(0.f, prev), cur); }

struct EpiConvA {
    static constexpr bool PERM = true, AFTER_DRAIN = false;
    bf16_t* G; const float* ssq; const float* wconv; float* cvbuf; float* gbuf;
    __device__ __forceinline__ void operator()(const f32x4 (&acc)[2][2][4][2], const Unit& u, int wr, int wc, int fr, int fq) const {
        const int e0 = u.pn * 64 + wc * 16 + fq * 4, row0 = u.pm * BM + wr * 64 + fr;
        const f32x4 w0 = *(const f32x4*)(wconv + e0), w1 = *(const f32x4*)(wconv + 1024 + e0), w2 = *(const f32x4*)(wconv + 2048 + e0);
#pragma unroll
        for (int ai = 0; ai < 2; ++ai) {
            f32x4 cvp = (f32x4){0.f, 0.f, 0.f, 0.f};
#pragma unroll
            for (int m = 0; m < 4; ++m) { const int row = row0 + ai * HALF + m * 16; const float rs = row_rs(ssq, row);
                const f32x4 b = acc[ai][0][m][0] * rs, z = acc[ai][1][m][1] * rs, cv = (acc[ai][0][m][1] * rs) * (acc[ai][1][m][0] * rs);
                f32x4 gb, y;
#pragma unroll
                for (int j = 0; j < 4; ++j) { const float s1 = row_up<1>(cv[j], cvp[j]), s2 = row_up<2>(cv[j], cvp[j]);
                    gb[j] = z[j] * sigmoidf_fast(z[j]) * b[j]; y[j] = gb[j] * (w0[j] * s2 + w1[j] * s1 + w2[j] * cv[j]); }
                typedef unsigned u32x2 __attribute__((ext_vector_type(2)));
                u32x2 o; o.x = cvt_pk_bf16(y[0], y[1]); o.y = cvt_pk_bf16(y[2], y[3]);
                *(u32x2*)(G + (size_t)row * 1024 + e0) = o;
                if (m == 0 && fr < 2) *(f32x4*)(gbuf + ((size_t)(row >> 6) * 2 + fr) * 1024 + e0) = gb;
                if (m == 3 && fr >= 14) *(f32x4*)(cvbuf + ((size_t)(row >> 6) * 2 + (fr - 14)) * 1024 + e0) = cv;
                cvp = cv; }
        }
    }
};
struct EpiPoolB {
    static constexpr bool PERM = true, AFTER_DRAIN = false;
    bf16_t* G; const float* ssq; const float* scale; float* hbuf; float* fbuf;
    template <int S> static __device__ __forceinline__ void step(f32x4 (&W)[4]) {
#pragma unroll
        for (int m = 3; m >= 0; --m)
#pragma unroll
            for (int j = 0; j < 4; ++j) W[m][j] += row_up<S>(W[m][j], m ? W[m - 1][j] : 0.f);
    }
    __device__ __forceinline__ void operator()(const f32x4 (&acc)[2][2][4][2], const Unit& u, int wr, int wc, int fr, int fq) const {
        const int ch0 = u.pn * 128 + wc * 32 + fq * 8, g = u.pn >> 1, w = 2 << g, row0 = u.pm * BM + wr * 64 + fr;
        typedef unsigned u32x2 __attribute__((ext_vector_type(2)));
#pragma unroll
        for (int ai = 0; ai < 2; ++ai) {
            float rs[4];
#pragma unroll
            for (int m = 0; m < 4; ++m) rs[m] = row_rs(ssq, row0 + ai * HALF + m * 16);
            u32x2 res[2][4];
#pragma unroll
            for (int n = 0; n < 2; ++n) {
                const f32x4 sc = *(const f32x4*)(scale + ch0 + 4 * n);
                f32x4 W[4];
#pragma unroll
                for (int m = 0; m < 4; ++m) W[m] = acc[ai][0][m][n] * rs[m];
                step<1>(W); if (g >= 1) step<2>(W); if (g >= 2) step<4>(W); if (g >= 3) step<8>(W);
#pragma unroll
                for (int m = 0; m < 4; ++m) { const int row = row0 + ai * HALF + m * 16, tt = row & 4095; const int cnt = (tt + 1) < w ? (tt + 1) : w; const float inv = __builtin_amdgcn_rcpf((float)cnt);
                    const f32x4 uu = acc[ai][0][m][n] * rs[m], zz = acc[ai][1][m][n] * rs[m]; f32x4 fz, o;
#pragma unroll
                    for (int j = 0; j < 4; ++j) { fz[j] = zz[j] * sigmoidf_fast(zz[j]) * sc[j]; o[j] = fz[j] * (W[m][j] * inv - uu[j]); }
                    res[n][m].x = cvt_pk_bf16(o[0], o[1]); res[n][m].y = cvt_pk_bf16(o[2], o[3]);
                    if (m == 0 && fr < 15) *(f32x4*)(fbuf + ((size_t)(row >> 6) * 15 + fr) * 1024 + ch0 + 4 * n) = fz * inv;
                    if (m == 3 && fr >= 1) *(f32x4*)(hbuf + ((size_t)(row >> 6) * 15 + (fr - 1)) * 1024 + ch0 + 4 * n) = uu; }
            }
#pragma unroll
            for (int m = 0; m < 4; ++m) { u32x4 o; o.x = res[0][m].x; o.y = res[0][m].y; o.z = res[1][m].x; o.w = res[1][m].y;
                *(u32x4*)(G + (size_t)(row0 + ai * HALF + m * 16) * 1024 + ch0) = o; }
        }
    }
};
struct EpiPP {
    static constexpr bool PERM = true, AFTER_DRAIN = false;
    bf16_t* O;
    __device__ __forceinline__ void operator()(const f32x4 (&acc)[2][2][4][2], const Unit& u, int wr, int wc, int fr, int fq) const {
        const int row0 = u.pm * BM + wr * 64 + fr, col0 = (u.pn & 3) * BM + wc * 32 + 8 * fq;
#pragma unroll
        for (int ai = 0; ai < 2; ++ai)
#pragma unroll
            for (int m = 0; m < 4; ++m) { bf16_t* rowp = O + (size_t)(row0 + ai * HALF + m * 16) * 1024 + col0;
#pragma unroll
                for (int bj = 0; bj < 2; ++bj) { const f32x4 v0 = acc[ai][bj][m][0], v1 = acc[ai][bj][m][1];
                    u32x4 w; w.x = cvt_pk_bf16(v0[0], v0[1]); w.y = cvt_pk_bf16(v0[2], v0[3]); w.z = cvt_pk_bf16(v1[0], v1[1]); w.w = cvt_pk_bf16(v1[2], v1[3]);
                    *(u32x4*)(rowp + bj * HALF) = w; } }
    }
};
struct EpiResid {
    static constexpr bool PERM = true, AFTER_DRAIN = false;
    const bf16_t* Hin; bf16_t* Hb; float* ssq_out;
    __device__ __forceinline__ void operator()(const f32x4 (&acc)[2][2][4][2], const Unit& u, int wr, int wc, int fr, int fq) const {
        const int row0 = u.pm * BM + wr * 64 + fr, col0 = u.pn * BM + wc * 32 + 8 * fq;
#pragma unroll
        for (int ai = 0; ai < 2; ++ai)
#pragma unroll
            for (int m = 0; m < 4; ++m) { const int row = row0 + ai * HALF + m * 16; const size_t off = (size_t)row * 1024 + col0; float s = 0.f;
#pragma unroll
                for (int bj = 0; bj < 2; ++bj) {
                    const u32x4 hw = *(const u32x4*)(Hin + off + bj * HALF);
                    f32x4 v0 = acc[ai][bj][m][0], v1 = acc[ai][bj][m][1];
                    v0[0] += bf_lo(hw.x); v0[1] += bf_hi(hw.x); v0[2] += bf_lo(hw.y); v0[3] += bf_hi(hw.y);
                    v1[0] += bf_lo(hw.z); v1[1] += bf_hi(hw.z); v1[2] += bf_lo(hw.w); v1[3] += bf_hi(hw.w);
                    u32x4 w; w.x = cvt_pk_bf16(v0[0], v0[1]); w.y = cvt_pk_bf16(v0[2], v0[3]); w.z = cvt_pk_bf16(v1[0], v1[1]); w.w = cvt_pk_bf16(v1[2], v1[3]);
                    *(u32x4*)(Hb + off + bj * HALF) = w;
                    s += ((v0[0] * v0[0] + v0[1] * v0[1]) + (v0[2] * v0[2] + v0[3] * v0[3])) + ((v1[0] * v1[0] + v1[1] * v1[1]) + (v1[2] * v1[2] + v1[3] * v1[3])); }
                s += __shfl_xor(s, 16); s += __shfl_xor(s, 32);
                if (fq == 0) ssq_out[(size_t)row * 16 + u.pn * 4 + wc] = s; }
    }
};
struct EpiPle {
    static constexpr bool PERM = true, AFTER_DRAIN = false;
    const bf16_t* Hin; bf16_t* Hb; const bf16_t* PP; const float* ssq_in; float* ssq_out;
    __device__ __forceinline__ void operator()(const f32x4 (&acc)[2][2][4][2], const Unit& u, int wr, int wc, int fr, int fq) const {
        const int row0 = u.pm * BM + wr * 64 + fr, col0 = u.pn * BM + wc * 32 + 8 * fq;
#pragma unroll
        for (int ai = 0; ai < 2; ++ai)
#pragma unroll
            for (int m = 0; m < 4; ++m) { const int row = row0 + ai * HALF + m * 16; const size_t off = (size_t)row * 1024 + col0; float s = 0.f; const float rs = row_rs(ssq_in, row);
#pragma unroll
                for (int bj = 0; bj < 2; ++bj) {
                    const u32x4 pw = *(const u32x4*)(PP + off + bj * HALF);
                    const u32x4 hw = *(const u32x4*)(Hin + off + bj * HALF);
                    const f32x4 a0 = acc[ai][bj][m][0] * rs, a1 = acc[ai][bj][m][1] * rs;
                    f32x4 v0, v1;
                    v0[0] = bf_lo(hw.x) + sigmoidf_fast(a0[0]) * bf_lo(pw.x); v0[1] = bf_hi(hw.x) + sigmoidf_fast(a0[1]) * bf_hi(pw.x);
                    v0[2] = bf_lo(hw.y) + sigmoidf_fast(a0[2]) * bf_lo(pw.y); v0[3] = bf_hi(hw.y) + sigmoidf_fast(a0[3]) * bf_hi(pw.y);
                    v1[0] = bf_lo(hw.z) + sigmoidf_fast(a1[0]) * bf_lo(pw.z); v1[1] = bf_hi(hw.z) + sigmoidf_fast(a1[1]) * bf_hi(pw.z);
                    v1[2] = bf_lo(hw.w) + sigmoidf_fast(a1[2]) * bf_lo(pw.w); v1[3] = bf_hi(hw.w) + sigmoidf_fast(a1[3]) * bf_hi(pw.w);
                    u32x4 w; w.x = cvt_pk_bf16(v0[0], v0[1]); w.y = cvt_pk_bf16(v0[2], v0[3]); w.z = cvt_pk_bf16(v1[0], v1[1]); w.w = cvt_pk_bf16(v1[2], v1[3]);
                    *(u32x4*)(Hb + off + bj * HALF) = w;
                    s += ((v0[0] * v0[0] + v0[1] * v0[1]) + (v0[2] * v0[2] + v0[3] * v0[3])) + ((v1[0] * v1[0] + v1[1] * v1[1]) + (v1[2] * v1[2] + v1[3] * v1[3])); }
                s += __shfl_xor(s, 16); s += __shfl_xor(s, 32);
                if (fq == 0) ssq_out[(size_t)row * 16 + u.pn * 4 + wc] = s; }
    }
};
struct PPOrder {
    StaticOrder so;
    __device__ void init(int G_, int c_) { so.init(32768, 1024, G_, 0); so.G = G_; so.c = c_; }
    __device__ bool next(int i, Unit& u) const {
        const long L = (long)i * so.G + so.c; if (L >= 2048) return false;
        const int layer = (int)(L >> 9), Ll = (int)(L & 511);
        StaticOrder t = so; t.G = 512; t.c = Ll; Unit v; t.next(0, v);
        u.pm = layer * 128 + v.pm; u.pn = layer * 4 + v.pn; return true;
    }
    __device__ __forceinline__ void a_ready(const Unit&) const {}
    __device__ __forceinline__ void done(const Unit&) const {}
};
template <class Epi, class Sched, bool ALIGN_EPI = false, bool SP2 = false>
__device__ __forceinline__ void gemm_phase(PG8_LAS unsigned char* lds, const Gemm g, const Sched& S, const Epi& E) {
    int tid_o = threadIdx.x; asm volatile("" : "+v"(tid_o));
    const int tid = tid_o, wid = __builtin_amdgcn_readfirstlane(tid >> 6), lane = tid & 63, wr = wid >> 2, wc = wid & 3, fr = lane & 15, fq = lane >> 4;
    const int K = g.K, nt = K / BK;
    unsigned voffA[2], voffB[2];
#pragma unroll
    for (int i = 0; i < 2; ++i) { int R, C; stage_rc(tid * 16 + i * 8192, R, C); const int Rb = Epi::PERM ? ((R & ~31) + perm32(R & 31)) : R;
        voffA[i] = (unsigned)(R * K + C) * 2u; voffB[i] = (unsigned)(Rb * K + C) * 2u; }
    const size_t kstep = (size_t)(BK * 2);
    const size_t hstep = (size_t)HALF * K * 2;
    const size_t tstep = 2 * hstep;
    const unsigned ldsw = (unsigned)wid * 1024u;
    const int aoff = lds_byte(wr * 64 + fr, fq * 8), boff = lds_byte(wc * 32 + fr, fq * 8);
#define PG8_SA(b, h) (((b) * 2 + (h)) * HTB)
#define PG8_SB(b, h) ((4 + (b) * 2 + (h)) * HTB)
#define PG8_STAGE(bufoff, gbase, voff) do { _Pragma("unroll") for (int _i = 0; _i < 2; ++_i) \
        __builtin_amdgcn_global_load_lds((const unsigned*)((const char*)(gbase) + (voff)[_i]), (PG8_LAS unsigned*)(lds + (bufoff) + ldsw + _i * 8192), 16, 0, 0); } while (0)
#define PG8_LDA(dst, b, h) do { _Pragma("unroll") for (int m = 0; m < 4; ++m) _Pragma("unroll") for (int k = 0; k < 2; ++k) dst[m][k] = *(const PG8_LAS bf16x8*)(lds + PG8_SA(b, h) + aoff + m * 2048 + k * 1024); } while (0)
#define PG8_LDB(dst, b, h) do { _Pragma("unroll") for (int n = 0; n < 2; ++n) _Pragma("unroll") for (int k = 0; k < 2; ++k) dst[n][k] = *(const PG8_LAS bf16x8*)(lds + PG8_SB(b, h) + boff + n * 2048 + k * 1024); } while (0)
#define PG8_MMA(ai, bj, At, Bt) do { __builtin_amdgcn_s_setprio(1); _Pragma("unroll") for (int m = 0; m < 4; ++m) _Pragma("unroll") for (int n = 0; n < 2; ++n) _Pragma("unroll") for (int k = 0; k < 2; ++k) \
        acc[ai][bj][m][n] = __builtin_amdgcn_mfma_f32_16x16x32_bf16(Bt[n][k], At[m][k], acc[ai][bj][m][n], 0, 0, 0); __builtin_amdgcn_s_setprio(0); } while (0)
#define PG8_WAIT_V(n) asm volatile("s_waitcnt vmcnt(" #n ")" ::: "memory")
#define PG8_WAIT_L(n) asm volatile("s_waitcnt lgkmcnt(" #n ")" ::: "memory")
#define PG8_BAR __builtin_amdgcn_s_barrier()
#define PG8_SCHED __builtin_amdgcn_sched_barrier(0)
    Unit cur, nxt; int ui = 0;
    if (!S.next(0, cur)) return;
    f32x4 acc[2][2][4][2];
#pragma unroll
    for (int a = 0; a < 2; ++a)
#pragma unroll
        for (int b = 0; b < 2; ++b)
#pragma unroll
            for (int m = 0; m < 4; ++m)
#pragma unroll
                for (int n = 0; n < 2; ++n) acc[a][b][m][n] = (f32x4){0.f, 0.f, 0.f, 0.f};
    bf16x8 At[4][2], B0[2][2], B1[2][2];
    const char* cA = (const char*)g.A + (size_t)cur.pm * tstep; const char* cB = (const char*)g.Bt + (size_t)cur.pn * tstep;
    S.a_ready(cur);
    if constexpr (SP2) {
        PG8_STAGE(PG8_SB(0, 0), cB, voffB); PG8_STAGE(PG8_SB(0, 1), cB + hstep, voffB); PG8_STAGE(PG8_SA(0, 0), cA, voffA); PG8_STAGE(PG8_SA(0, 1), cA + hstep, voffA);
        if (wr == 1) PG8_BAR;
        PG8_WAIT_V(2); PG8_BAR;
        PG8_STAGE(PG8_SB(1, 0), cB + kstep, voffB); PG8_STAGE(PG8_SA(1, 0), cA + kstep, voffA); PG8_STAGE(PG8_SB(1, 1), cB + hstep + kstep, voffB);
        PG8_WAIT_V(6); PG8_BAR;
    } else {
        PG8_STAGE(PG8_SB(0, 0), cB, voffB); PG8_STAGE(PG8_SA(0, 0), cA, voffA); PG8_STAGE(PG8_SB(0, 1), cB + hstep, voffB); PG8_STAGE(PG8_SA(0, 1), cA + hstep, voffA);
        if (wr == 1) PG8_BAR;
        PG8_WAIT_V(4); PG8_BAR;
        PG8_STAGE(PG8_SB(1, 0), cB + kstep, voffB); PG8_STAGE(PG8_SA(1, 0), cA + kstep, voffA); PG8_STAGE(PG8_SB(1, 1), cB + hstep + kstep, voffB);
        PG8_WAIT_V(6); PG8_BAR;
    }
    for (;;) {
        const bool has_next = S.next(ui + 1, nxt);
        const char* nA = has_next ? (const char*)g.A + (size_t)nxt.pm * tstep : cA; const char* nB = has_next ? (const char*)g.Bt + (size_t)nxt.pn * tstep : cB;
        _Pragma("nounroll") for (int t = 0; t < nt; t += 2) {
            const bool last = (t == nt - 2);
            const char* a1 = cA + (size_t)(t + 1) * kstep;
            const char* a2 = last ? nA : cA + (size_t)(t + 2) * kstep; const char* b2 = last ? nB : cB + (size_t)(t + 2) * kstep;
            const char* a3 = a2 + kstep; const char* b3 = b2 + kstep;
            if (last && has_next) S.a_ready(nxt);
            if constexpr (SP2) {
            PG8_LDB(B0, 0, 0); PG8_LDB(B1, 0, 1); PG8_SCHED; PG8_LDA(At, 0, 0); PG8_STAGE(PG8_SA(1, 1), a1 + hstep, voffA);
            PG8_WAIT_V(8); PG8_WAIT_L(0); PG8_BAR; PG8_MMA(0, 0, At, B0); PG8_MMA(0, 1, At, B1); PG8_BAR; PG8_SCHED;
            PG8_LDA(At, 0, 1); PG8_STAGE(PG8_SB(0, 0), b2, voffB); PG8_STAGE(PG8_SB(0, 1), b2 + hstep, voffB); PG8_STAGE(PG8_SA(0, 0), a2, voffA);
            PG8_WAIT_V(8); PG8_WAIT_L(0); PG8_BAR; PG8_MMA(1, 0, At, B0); PG8_MMA(1, 1, At, B1); PG8_BAR; PG8_SCHED;
            PG8_LDB(B0, 1, 0); PG8_LDB(B1, 1, 1); PG8_SCHED; PG8_LDA(At, 1, 0); PG8_STAGE(PG8_SA(0, 1), a2 + hstep, voffA);
            PG8_WAIT_V(8); PG8_WAIT_L(0); PG8_BAR; PG8_MMA(0, 0, At, B0); PG8_MMA(0, 1, At, B1); PG8_BAR; PG8_SCHED;
            PG8_LDA(At, 1, 1); PG8_STAGE(PG8_SB(1, 0), b3, voffB); PG8_STAGE(PG8_SB(1, 1), b3 + hstep, voffB); PG8_STAGE(PG8_SA(1, 0), a3, voffA);
            PG8_WAIT_V(8); PG8_WAIT_L(0); PG8_BAR; PG8_MMA(1, 0, At, B0); PG8_MMA(1, 1, At, B1); PG8_BAR; PG8_SCHED;
            } else {
            PG8_LDB(B0, 0, 0); PG8_SCHED; PG8_LDA(At, 0, 0); PG8_STAGE(PG8_SA(1, 1), a1 + hstep, voffA);
            PG8_WAIT_L(8); PG8_BAR; PG8_WAIT_L(0); PG8_MMA(0, 0, At, B0); PG8_BAR; PG8_SCHED;
            PG8_LDB(B1, 0, 1); PG8_STAGE(PG8_SB(0, 0), b2, voffB);
            PG8_BAR; PG8_WAIT_L(0); PG8_MMA(0, 1, At, B1); PG8_BAR;
            PG8_LDA(At, 0, 1); PG8_STAGE(PG8_SA(0, 0), a2, voffA);
            PG8_BAR; PG8_WAIT_L(0); PG8_MMA(1, 0, At, B0); PG8_BAR; PG8_SCHED;
            PG8_STAGE(PG8_SB(0, 1), b2 + hstep, voffB);
            PG8_WAIT_V(6); PG8_BAR; PG8_MMA(1, 1, At, B1); PG8_BAR;
            PG8_LDB(B0, 1, 0); PG8_SCHED; PG8_LDA(At, 1, 0); PG8_STAGE(PG8_SA(0, 1), a2 + hstep, voffA);
            PG8_WAIT_L(8); PG8_BAR; PG8_WAIT_L(0); PG8_MMA(0, 0, At, B0); PG8_BAR; PG8_SCHED;
            PG8_LDB(B1, 1, 1); PG8_STAGE(PG8_SB(1, 0), b3, voffB);
            PG8_BAR; PG8_WAIT_L(0); PG8_MMA(0, 1, At, B1); PG8_BAR;
            PG8_LDA(At, 1, 1); PG8_STAGE(PG8_SA(1, 0), a3, voffA);
            PG8_BAR; PG8_WAIT_L(0); PG8_MMA(1, 0, At, B0); PG8_BAR; PG8_SCHED;
            PG8_STAGE(PG8_SB(1, 1), b3 + hstep, voffB);
            PG8_WAIT_V(6); PG8_BAR; PG8_MMA(1, 1, At, B1); PG8_BAR;
            }
        }
        if constexpr (ALIGN_EPI) { if (wr == 0) PG8_BAR; }
        if constexpr (!Epi::AFTER_DRAIN) { E(acc, cur, wr, wc, fr, fq); S.done(cur); }
        if (!has_next) break;
#pragma unroll
        for (int a = 0; a < 2; ++a)
#pragma unroll
            for (int b = 0; b < 2; ++b)
#pragma unroll
                for (int m = 0; m < 4; ++m)
#pragma unroll
                    for (int n = 0; n < 2; ++n) acc[a][b][m][n] = (f32x4){0.f, 0.f, 0.f, 0.f};
        cur = nxt; cA = nA; cB = nB; ++ui;
        if constexpr (ALIGN_EPI) { if (wr == 1) PG8_BAR; }
    }
    PG8_WAIT_V(0);
    if constexpr (!ALIGN_EPI) { if (wr == 0) PG8_BAR; }
    PG8_BAR;
    if constexpr (Epi::AFTER_DRAIN) { E.fused(acc, cur, wr, wc, fr, fq, lds, wid, lane); S.done(cur); }
#undef PG8_SA
#undef PG8_SB
#undef PG8_STAGE
#undef PG8_LDA
#undef PG8_LDB
#undef PG8_MMA
#undef PG8_WAIT_V
#undef PG8_WAIT_L
#undef PG8_BAR
#undef PG8_SCHED
}
}
#define GAS __attribute__((address_space(1)))
#define LAS __attribute__((address_space(3)))
typedef unsigned short bf16;
typedef unsigned v4u __attribute__((ext_vector_type(4)));
typedef float f32x4 __attribute__((ext_vector_type(4)));
typedef short bf16x8 __attribute__((ext_vector_type(8)));
typedef GAS unsigned gu32;
typedef GAS unsigned long long gu64;
#define RLX_AGENT __ATOMIC_RELAXED, __HIP_MEMORY_SCOPE_AGENT
#define LDS_WAIT() asm volatile("s_waitcnt lgkmcnt(0)" ::: "memory")
#define VM_WAIT() asm volatile("s_waitcnt vmcnt(0)" ::: "memory")
__device__ __forceinline__ unsigned long long rt() { return __builtin_amdgcn_s_memrealtime(); }
__device__ __forceinline__ unsigned f2bf(float f) { unsigned u = __builtin_bit_cast(unsigned, f); return (u + 0x7fffu + ((u >> 16) & 1u)) >> 16; }
__device__ __forceinline__ unsigned pk2(float lo, float hi) { return f2bf(lo) | (f2bf(hi) << 16); }

#define XB_TMO      128
#define XB_XCNT(j)  (256  + 64 * (j))
#define XB_XSUB(j)  (1280 + 64 * (j))
#define XB_XGEN(j)  (2304 + 64 * (j))
#define XB_TOP      3328
#define XB_TOPGEN   3392
#define XCD_BAR_WORDS 3456
#define XB_SPIN_CAP (1u << 18)

__device__ __forceinline__ unsigned xb_ld(unsigned* p)              { return __hip_atomic_load(p, __ATOMIC_RELAXED, __HIP_MEMORY_SCOPE_AGENT); }
__device__ __forceinline__ unsigned xb_add(unsigned* p, unsigned v) { return __hip_atomic_fetch_add(p, v, __ATOMIC_RELAXED, __HIP_MEMORY_SCOPE_AGENT); }
__device__ __forceinline__ unsigned xb_xcc_id() { return (unsigned)__builtin_amdgcn_s_getreg((3 << 11) | 20) & 0xFu; }
#define XB_SPIN(cond, bar) do { unsigned _sp = 0; while (cond) { __builtin_amdgcn_s_sleep(1); \
    if ((++_sp & 255u) == 0u) { if (xb_ld(&(bar)[XB_TMO])) break; if (_sp > XB_SPIN_CAP) { atomicAdd(&(bar)[XB_TMO], 1u); break; } } } } while (0)

struct XcdBarrier {
    unsigned* bar; unsigned x;
    volatile LAS unsigned* st;
};

__device__ __forceinline__ XcdBarrier xcd_barrier_post(unsigned* bar, volatile LAS unsigned* st) {
    XcdBarrier b; b.bar = bar; b.x = xb_xcc_id(); b.st = st;
    if (threadIdx.x == 0) (void)xb_add(&bar[XB_XCNT(b.x)], 1u);
    return b;
}
__device__ __forceinline__ void xcd_barrier_complete(unsigned* bar, unsigned x, unsigned& nloc, unsigned& nx) {
    const unsigned G = gridDim.x * gridDim.y * gridDim.z;
    unsigned sum, cnt, mine, sp = 0u;
    for (;;) {
        sum = 0u; cnt = 0u; mine = 0u;
#pragma unroll
        for (unsigned j = 0; j < 16; ++j) { const unsigned c = xb_ld(&bar[XB_XCNT(j)]); sum += c; cnt += (c > 0u) ? 1u : 0u; mine = (j == x) ? c : mine; }
        if (sum == G) break;
        __builtin_amdgcn_s_sleep(1);
        if ((++sp & 255u) == 0u) { if (xb_ld(&bar[XB_TMO])) break; if (sp > XB_SPIN_CAP) { atomicAdd(&bar[XB_TMO], 1u); break; } }
    }
    nloc = mine > 0u ? mine : 1u; nx = cnt > 0u ? cnt : 1u;
}

__device__ __forceinline__ void xcd_barrier(const XcdBarrier& b) {
    asm volatile("s_waitcnt vmcnt(0)" ::: "memory");
    __syncthreads();
    if (threadIdx.x == 0) {
        unsigned* bar = b.bar;
        __builtin_amdgcn_s_waitcnt(0);
        unsigned nloc = b.st[0], nx = b.st[1];
        if (nloc == 0u) { xcd_barrier_complete(bar, b.x, nloc, nx); b.st[0] = nloc; b.st[1] = nx; }
        const unsigned old = xb_add(&bar[XB_XSUB(b.x)], 1u);
        const unsigned gen = old / nloc;
        if (old + 1u == (gen + 1u) * nloc) {
            __builtin_amdgcn_fence(__ATOMIC_RELEASE, "agent");
            asm volatile("s_waitcnt vmcnt(0)" ::: "memory");
            const unsigned og = xb_add(&bar[XB_TOP], 1u);
            const unsigned tg = og / nx;
            if (og + 1u == (tg + 1u) * nx) xb_add(&bar[XB_TOPGEN], 1u);
            else XB_SPIN(xb_ld(&bar[XB_TOPGEN]) == tg, bar);
            __builtin_amdgcn_fence(__ATOMIC_ACQUIRE, "agent");
            xb_add(&bar[XB_XGEN(b.x)], 1u);
            asm volatile("s_waitcnt vmcnt(0)" ::: "memory");
        } else {
            XB_SPIN(xb_ld(&bar[XB_XGEN(b.x)]) == gen, bar);
            __builtin_amdgcn_fence(__ATOMIC_ACQUIRE, "agent");
            asm volatile("s_waitcnt vmcnt(0)" ::: "memory");
        }
    }
    __syncthreads();
}
using pg8::bf_lo; using pg8::bf_hi;

constexpr int NWAVES = 8;
constexpr int M = 32768, D = 1024, SEQ = 4096, DEPTH = 4, PLE = 256;
constexpr float EPS = 1e-6f;
#ifndef EN_MASK
#define EN_MASK 0xff
#endif
#ifndef MK_MULTI
#define MK_MULTI 0
#endif
constexpr size_t MiB = 1u << 20;
constexpr size_t WS_CTL = 0, CTL_ZERO_BYTES = 1 * MiB;
constexpr size_t WS_WAIN = 2 * MiB;
constexpr size_t WS_WAOUT = 18 * MiB;
constexpr size_t WS_WBIN = 22 * MiB;
constexpr size_t WS_WBOUT = 30 * MiB;
constexpr size_t WS_WG = 34 * MiB;
constexpr size_t WS_WP = 42 * MiB;
constexpr size_t WS_SSQA = 44 * MiB, WS_SSQB = 46 * MiB;
constexpr size_t WS_CVBUF = 48 * MiB, WS_GBUF = 52 * MiB;
constexpr size_t WS_HB0 = 64 * MiB, WS_HB1 = 128 * MiB, WS_G = 192 * MiB, WS_PP = 256 * MiB, WS_END = 512 * MiB;
constexpr size_t WS_PB = WS_HB1;
constexpr size_t WS_HBUF = WS_PP, WS_FBUF = WS_PP + 32 * MiB;
constexpr int CW_BAR = 4096;
constexpr int RING_OFF = 0, RING_BYTES = 131072;
constexpr int LDSCTL_OFF = RING_BYTES, MISC_OFF = LDSCTL_OFF + 320;
constexpr int LDS_BYTES = 147456;

struct Frame {
    LAS unsigned char* lds;
    volatile LAS unsigned* MISC;
    int tid, lane, wave, vcu, G;
};
__device__ __forceinline__ float wave_sum(float v) {
#pragma unroll
    for (int o = 1; o < 64; o <<= 1) v += __shfl_xor(v, o);
    return v;
}
typedef unsigned v2u __attribute__((ext_vector_type(2)));
__device__ __forceinline__ unsigned pk_bf16(float lo, float hi) { return pg8::cvt_pk_bf16(lo, hi); }

template <int MAP> __device__ __forceinline__ int rowmap(int n) {
    if (MAP == 1) { const int type = n >> 10, e = n & 1023; return 256 * (e >> 6) + 128 * (type >> 1) + 32 * ((e & 63) >> 4) + 8 * ((e >> 2) & 3) + 4 * (type & 1) + (e & 3); }
    if (MAP == 2) { return 256 * (n >> 7) + 128 + (n & 127); }
    return n;
}
template <int MAP>
__device__ __forceinline__ void transpose_item(const float* W, int ldw, int ncols, int K, const float* gk, bf16* WT, LAS float* scr, int item, int lane) {
    const int nblk = ncols / 32, kb = item / nblk, nb = item % nblk, k0 = 64 * kb, n0 = 32 * nb;
#pragma unroll 8
    for (int i = 0; i < 32; ++i) { const int kk = 2 * i + (lane >> 5); float v = W[(size_t)(k0 + kk) * ldw + n0 + (lane & 31)]; if (gk) v *= gk[k0 + kk]; scr[kk * 33 + (lane & 31)] = v; }
    LDS_WAIT(); asm volatile("" ::: "memory");
    const int c = lane & 7;
#pragma unroll
    for (int j = 0; j < 4; ++j) { const int n = (lane >> 3) + 8 * j; const LAS float* s = scr + (8 * c) * 33 + n;
        v4u o; o.x = pk_bf16(s[0 * 33], s[1 * 33]); o.y = pk_bf16(s[2 * 33], s[3 * 33]); o.z = pk_bf16(s[4 * 33], s[5 * 33]); o.w = pk_bf16(s[6 * 33], s[7 * 33]);
        *(GAS v4u*)(WT + (size_t)rowmap<MAP>(n0 + n) * K + k0 + 8 * c) = o; }
    LDS_WAIT(); asm volatile("" ::: "memory");
}
typedef float f32x16 __attribute__((ext_vector_type(16)));
__device__ __forceinline__ void fold_item(const float* win  , const float* wgrp  , const float* nm, bf16* WT, int item, int lane) {
    const int g = item >> 8, kt = (item >> 3) & 31, dt = item & 7, k0 = 32 * kt, d0 = 32 * dt, h = lane >> 5, l31 = lane & 31;
    f32x16 acc;
#pragma unroll
    for (int q = 0; q < 16; ++q) acc[q] = 0.f;
    const float* arow = win + (size_t)(k0 + l31) * 2048 + g * 256 + 4 * h;
    const float* bcol = wgrp + (size_t)g * 65536 + (size_t)(4 * h) * 256 + d0 + l31;
#pragma unroll 4
    for (int c0 = 0; c0 < 256; c0 += 8) {
        const f32x4 a = *(const f32x4*)(arow + c0);
#pragma unroll
        for (int j = 0; j < 4; ++j) { const float b = bcol[(size_t)(c0 + j) * 256]; acc = __builtin_amdgcn_mfma_f32_32x32x2f32(a[j], b, acc, 0, 0, 0); }
    }
    const int e = g * 256 + d0 + l31; bf16* orow = WT + (size_t)(256 * (e >> 7) + (e & 127)) * 1024 + k0 + 4 * h;
#pragma unroll
    for (int qq = 0; qq < 4; ++qq) { const int kb = k0 + 8 * qq + 4 * h; const f32x4 gn = *(const f32x4*)(nm + kb);
        v2u o; o.x = pk_bf16(acc[4 * qq + 0] * gn[0], acc[4 * qq + 1] * gn[1]); o.y = pk_bf16(acc[4 * qq + 2] * gn[2], acc[4 * qq + 3] * gn[3]);
        *(GAS v2u*)(orow + 8 * qq) = o; }
}
__device__ __forceinline__ void x_row(const float* xrow, bf16* orow, float* ssq, int lane) {
    const GAS f32x4* xr = (const GAS f32x4*)xrow + lane;
    f32x4 v[4]; float s = 0.f;
#pragma unroll
    for (int j = 0; j < 4; ++j) { v[j] = xr[64 * j]; s += (v[j][0] * v[j][0] + v[j][1] * v[j][1]) + (v[j][2] * v[j][2] + v[j][3] * v[j][3]); }
    s = wave_sum(s);
    GAS v2u* o8 = (GAS v2u*)orow + lane;
#pragma unroll
    for (int j = 0; j < 4; ++j) { v2u o; o.x = pk_bf16(v[j][0], v[j][1]); o.y = pk_bf16(v[j][2], v[j][3]); o8[64 * j] = o; }
    if (lane < 16) ssq[lane] = lane == 0 ? s : 0.f;
}
__device__ __forceinline__ void convert_p(const Frame& F, const float* p, bf16* pb) {
    const size_t n8 = (size_t)DEPTH * M * PLE / 8, stride = (size_t)F.G * NWAVES * 64;
    for (size_t i = (size_t)(F.vcu * NWAVES + F.wave) * 64 + F.lane; i < n8; i += stride) {
        const f32x4 a = *(const GAS f32x4*)(p + 8 * i), b = *(const GAS f32x4*)(p + 8 * i + 4);
        v4u o; o.x = pk_bf16(a[0], a[1]); o.y = pk_bf16(a[2], a[3]); o.z = pk_bf16(b[0], b[1]); o.w = pk_bf16(b[2], b[3]);
        *(GAS v4u*)(pb + 8 * i) = o; }
}
__device__ __forceinline__ float silu_f(float z) { return z * pg8::sigmoidf_fast(z); }

struct Args { const float* in[14]; float* out; unsigned char* ws; int ph_lo, ph_hi; };
constexpr int NPH = 2 + 4 * DEPTH;

__global__ void __launch_bounds__(NWAVES * 64, 2) mk_fwd(Args args) {
    extern __shared__ __attribute__((aligned(16))) unsigned char lds_raw[];
    Frame F;
    F.lds = (LAS unsigned char*)lds_raw;
    F.MISC = (volatile LAS unsigned*)(F.lds + MISC_OFF);
    F.tid = threadIdx.x; F.lane = F.tid & 63; F.wave = __builtin_amdgcn_readfirstlane(F.tid >> 6);
    F.G = gridDim.x; { const int bx = blockIdx.x; F.vcu = (F.G % 8 == 0) ? (bx % 8) * (F.G / 8) + bx / 8 : bx; }
    unsigned char* ws = args.ws;
    const float* x = args.in[0]; const float* p = args.in[1]; const float* norm_mix = args.in[2]; const float* a_w_in = args.in[3]; const float* a_w_conv = args.in[4];
    const float* a_w_out = args.in[5]; const float* b_w_in = args.in[6]; const float* b_w_grp = args.in[7]; const float* b_scale = args.in[8]; const float* b_w_out = args.in[9];
    const float* ple_norm = args.in[10]; const float* ple_w_gate = args.in[11]; const float* ple_w_proj = args.in[12]; const float* final_norm = args.in[13];
    float* out = args.out;
    bf16* WAin = (bf16*)(ws + WS_WAIN); bf16* WAout = (bf16*)(ws + WS_WAOUT); bf16* WBin = (bf16*)(ws + WS_WBIN); bf16* WBout = (bf16*)(ws + WS_WBOUT);
    bf16* WG = (bf16*)(ws + WS_WG); bf16* WP = (bf16*)(ws + WS_WP); float* SSQA = (float*)(ws + WS_SSQA); float* SSQB = (float*)(ws + WS_SSQB);
    bf16* PB = (bf16*)(ws + WS_PB); bf16* HB0 = (bf16*)(ws + WS_HB0); bf16* HB1 = (bf16*)(ws + WS_HB1); bf16* GB = (bf16*)(ws + WS_G); bf16* PP = (bf16*)(ws + WS_PP);
    float* CVBUF = (float*)(ws + WS_CVBUF); float* GBUF = (float*)(ws + WS_GBUF); float* HBUF = (float*)(ws + WS_HBUF); float* FBUF = (float*)(ws + WS_FBUF);

    for (int u = F.tid; u < (LDS_BYTES - LDSCTL_OFF) / 4; u += NWAVES * 64) ((LAS unsigned*)(F.lds + LDSCTL_OFF))[u] = 0u;
    __syncthreads();
    XcdBarrier bar; bar.bar = (unsigned*)(ws + WS_CTL) + CW_BAR; bar.x = 0; bar.st = nullptr;
    if (!MK_MULTI) bar = xcd_barrier_post((unsigned*)(ws + WS_CTL) + CW_BAR, F.MISC + 8);

    for (int ph = args.ph_lo; ph < args.ph_hi; ++ph) {
        { int t_ = threadIdx.x; asm volatile("" : "+v"(t_)); F.tid = t_; F.lane = t_ & 63; F.wave = __builtin_amdgcn_readfirstlane(t_ >> 6); }
        const int gw = F.vcu * NWAVES + F.wave, NGW = F.G * NWAVES;
        if (ph == 0) {
            LAS float* scr = (LAS float*)(F.lds + RING_OFF + F.wave * 16384);
            constexpr int I_AIN = 16 * 128, I_SQ = 16 * 32, I_WP = 4 * 32, I_FOLD = 1024;
            constexpr int N_AIN = 2 * I_AIN, N_AOUT = 2 * I_SQ, N_BZ = 2 * I_SQ, N_BOUT = 2 * I_SQ, N_WG = 4 * I_SQ, N_WP = 4 * I_WP, N_FOLD = 2 * I_FOLD;
            constexpr int NITEMS = N_FOLD + N_AIN + N_AOUT + N_BZ + N_BOUT + N_WG + N_WP;
            for (int it = gw; it < NITEMS; it += NGW) {
                int r = it;
                if (r < N_FOLD) { const int j = r / I_FOLD; fold_item(b_w_in + (size_t)j * 1024 * 2048, b_w_grp + (size_t)j * 4 * 65536, norm_mix + (2 * j + 1) * 1024, WBin + (size_t)j * 2048 * 1024, r % I_FOLD, F.lane); continue; } r -= N_FOLD;
                if (r < N_AIN) { const int j = r / I_AIN; transpose_item<1>(a_w_in + (size_t)j * 1024 * 4096, 4096, 4096, 1024, norm_mix + (2 * j) * 1024, WAin + (size_t)j * 4096 * 1024, scr, r % I_AIN, F.lane); continue; } r -= N_AIN;
                if (r < N_AOUT) { const int j = r / I_SQ; transpose_item<0>(a_w_out + (size_t)j * 1024 * 1024, 1024, 1024, 1024, nullptr, WAout + (size_t)j * 1024 * 1024, scr, r % I_SQ, F.lane); continue; } r -= N_AOUT;
                if (r < N_BZ) { const int j = r / I_SQ; transpose_item<2>(b_w_in + (size_t)j * 1024 * 2048 + 1024, 2048, 1024, 1024, norm_mix + (2 * j + 1) * 1024, WBin + (size_t)j * 2048 * 1024, scr, r % I_SQ, F.lane); continue; } r -= N_BZ;
                if (r < N_BOUT) { const int j = r / I_SQ; transpose_item<0>(b_w_out + (size_t)j * 1024 * 1024, 1024, 1024, 1024, nullptr, WBout + (size_t)j * 1024 * 1024, scr, r % I_SQ, F.lane); continue; } r -= N_BOUT;
                if (r < N_WG) { const int j = r / I_SQ; transpose_item<0>(ple_w_gate + (size_t)j * 1024 * 1024, 1024, 1024, 1024, ple_norm + j * 1024, WG + (size_t)j * 1024 * 1024, scr, r % I_SQ, F.lane); continue; } r -= N_WG;
                { const int j = r / I_WP; transpose_item<0>(ple_w_proj + (size_t)j * 256 * 1024, 1024, 1024, 256, nullptr, WP + (size_t)j * 1024 * 256, scr, r % I_WP, F.lane); }
            }
            for (int m = gw; m < M; m += NGW) x_row(x + (size_t)m * D, HB0 + (size_t)m * D, SSQB + (size_t)m * 16, F.lane);
            convert_p(F, p, PB);
        } else if (ph == NPH - 1) {
            for (int m = gw; m < M; m += NGW) {
                const float rs = pg8::row_rs(SSQB, m);
                const GAS v2u* hr = (const GAS v2u*)(HB0 + (size_t)m * D) + F.lane; GAS f32x4* orow = (GAS f32x4*)(out + (size_t)m * D) + F.lane;
#pragma unroll
                for (int j = 0; j < 4; ++j) { const f32x4 g = *((const GAS f32x4*)final_norm + F.lane + 64 * j); const v2u hw = hr[64 * j];
                    f32x4 o; o[0] = bf_lo(hw.x) * rs * g[0]; o[1] = bf_hi(hw.x) * rs * g[1]; o[2] = bf_lo(hw.y) * rs * g[2]; o[3] = bf_hi(hw.y) * rs * g[3]; orow[64 * j] = o; }
            }
        } else {
            const int i = (ph - 1) >> 2, s = (ph - 1) & 3, j = i >> 1; const bool isA = (i & 1) == 0;
            if (s == 0) {
                if (i == 0) {
                    pg8::Gemm g{PB, WP, DEPTH * M, DEPTH * D, PLE}; pg8::PPOrder S; S.init(F.G, (int)blockIdx.x);
                    pg8::EpiPP E{PP};
                    pg8::gemm_phase<pg8::EpiPP, pg8::PPOrder, true, true>(F.lds + RING_OFF, g, S, E);
                }
                if (isA) {
                    pg8::Gemm g{HB0, WAin + (size_t)j * 4096 * 1024, M, 4096, D}; pg8::StaticOrder S; S.init(M, 4096, F.G, (int)blockIdx.x);
                    pg8::EpiConvA E{GB, SSQB, a_w_conv + (size_t)j * 3 * 1024, CVBUF, GBUF};
                    pg8::gemm_phase<pg8::EpiConvA, pg8::StaticOrder, true, true>(F.lds + RING_OFF, g, S, E);
                } else {
                    pg8::Gemm g{HB0, WBin + (size_t)j * 2048 * 1024, M, 2048, D}; pg8::StaticOrder S; S.init(M, 2048, F.G, (int)blockIdx.x);
                    pg8::EpiPoolB E{GB, SSQB, b_scale + (size_t)j * 1024, HBUF, FBUF};
                    pg8::gemm_phase<pg8::EpiPoolB, pg8::StaticOrder, true, true>(F.lds + RING_OFF, g, S, E);
                }
            } else if (s == 1) {
                const size_t gt = (size_t)blockIdx.x * (NWAVES * 64) + F.tid, GT = (size_t)F.G * NWAVES * 64;
                if (isA) {
                    const float* wc0 = a_w_conv + (size_t)j * 3 * 1024;
                    for (size_t idx = gt; idx < (size_t)512 * 2 * 256; idx += GT) {
                        const int q = (int)(idx & 255), rr = (int)(idx >> 8) & 1, B = (int)(idx >> 9);
                        if ((B & 63) == 0) continue;
                        const int e0 = 4 * q;
                        const f32x4 gb = *(const GAS f32x4*)(GBUF + ((size_t)B * 2 + rr) * 1024 + e0);
                        const f32x4 c1 = *(const GAS f32x4*)(CVBUF + ((size_t)(B - 1) * 2 + 1) * 1024 + e0), c2 = *(const GAS f32x4*)(CVBUF + ((size_t)(B - 1) * 2 + 0) * 1024 + e0);
                        const f32x4 w0 = *(const GAS f32x4*)(wc0 + e0), w1 = *(const GAS f32x4*)(wc0 + 1024 + e0);
                        const f32x4 add = rr == 0 ? gb * (w0 * c2 + w1 * c1) : gb * (w0 * c1);
                        GAS v2u* gp = (GAS v2u*)(GB + ((size_t)B * 64 + rr) * 1024 + e0); const v2u gw2 = *gp;
                        v2u ow; ow.x = pk_bf16(bf_lo(gw2.x) + add[0], bf_hi(gw2.x) + add[1]); ow.y = pk_bf16(bf_lo(gw2.y) + add[2], bf_hi(gw2.y) + add[3]);
                        *gp = ow;
                    }
                } else {
                    for (size_t idx = gt; idx < (size_t)512 * 15 * 256; idx += GT) {
                        const int q = (int)(idx & 255), t2 = (int)(idx >> 8), rr = t2 % 15, B = t2 / 15;
                        const int e0 = 4 * q, w = 2 << (e0 >> 8);
                        if ((B & 63) == 0 || rr >= w - 1) continue;
                        const f32x4 fz = *(const GAS f32x4*)(FBUF + ((size_t)B * 15 + rr) * 1024 + e0);
                        f32x4 S = (f32x4){0.f, 0.f, 0.f, 0.f};
                        for (int slot = 16 + rr - w; slot < 15; ++slot) S += *(const GAS f32x4*)(HBUF + ((size_t)(B - 1) * 15 + slot) * 1024 + e0);
                        const f32x4 add = fz * S;
                        GAS v2u* gp = (GAS v2u*)(GB + ((size_t)B * 64 + rr) * 1024 + e0); const v2u gw2 = *gp;
                        v2u ow; ow.x = pk_bf16(bf_lo(gw2.x) + add[0], bf_hi(gw2.x) + add[1]); ow.y = pk_bf16(bf_lo(gw2.y) + add[2], bf_hi(gw2.y) + add[3]);
                        *gp = ow;
                    }
                }
            } else if (s == 2) {
                pg8::Gemm g{GB, isA ? WAout + (size_t)j * 1024 * 1024 : WBout + (size_t)j * 1024 * 1024, M, D, D}; pg8::StaticOrder S; S.init(M, D, F.G, (int)blockIdx.x);
                pg8::EpiResid E{HB0, HB1, SSQA};
                pg8::gemm_phase<pg8::EpiResid, pg8::StaticOrder, true, true>(F.lds + RING_OFF, g, S, E);
            } else {
                pg8::Gemm g{HB1, WG + (size_t)i * 1024 * 1024, M, D, D}; pg8::StaticOrder S; S.init(M, D, F.G, (int)blockIdx.x);
                pg8::EpiPle E{HB1, HB0, PP + (size_t)i * M * D, SSQA, SSQB};
                pg8::gemm_phase<pg8::EpiPle, pg8::StaticOrder, true, true>(F.lds + RING_OFF, g, S, E);
            }
        }
        if (ph + 1 < args.ph_hi) xcd_barrier(bar);
    }
}

extern "C" void kernel_launch(void* const* d_in, const int* in_sizes, int n_in, void* d_out, int out_size, void* d_ws, size_t ws_size, hipStream_t stream) {
    static int grid = 0;
    if (grid == 0) {
        if (n_in != 14 || in_sizes[0] != M * D || out_size != M * D || ws_size < WS_END) { fprintf(stderr, "kernel_launch: unexpected shapes (n_in %d, in0 %d, out %d, ws %zu); nothing launched\n", n_in, n_in > 0 ? in_sizes[0] : -1, out_size, ws_size); grid = -1; return; }
        int dev = 0, cus = 0, per_cu = 0;
        if (hipGetDevice(&dev) != hipSuccess || hipDeviceGetAttribute(&cus, hipDeviceAttributeMultiprocessorCount, dev) != hipSuccess) { grid = -1; return; }
        if (hipFuncSetAttribute((const void*)mk_fwd, hipFuncAttributeMaxDynamicSharedMemorySize, LDS_BYTES) != hipSuccess) { fprintf(stderr, "kernel_launch: hipFuncSetAttribute failed\n"); grid = -1; return; }
        if (hipOccupancyMaxActiveBlocksPerMultiprocessor(&per_cu, (const void*)mk_fwd, NWAVES * 64, LDS_BYTES) != hipSuccess || per_cu < 1) { fprintf(stderr, "kernel_launch: occupancy query says %d blocks per CU\n", per_cu); per_cu = 1; }
        (void)hipGetLastError();
        grid = cus;
    }
    if (grid < 0) return;
    (void)hipMemsetAsync((char*)d_ws + WS_CTL, 0, CTL_ZERO_BYTES, stream);
    Args a{};
    for (int i = 0; i < 14; ++i) a.in[i] = (const float*)d_in[i];
    a.out = (float*)d_out; a.ws = (unsigned char*)d_ws;
#if MK_MULTI
    for (int ph = 0; ph < NPH; ++ph) { a.ph_lo = ph; a.ph_hi = ph + 1; hipLaunchKernelGGL(mk_fwd, dim3(grid), dim3(NWAVES * 64), LDS_BYTES, stream, a); }
#else
    a.ph_lo = 0; a.ph_hi = NPH;
    hipLaunchKernelGGL(mk_fwd, dim3(grid), dim3(NWAVES * 64), LDS_BYTES, stream, a);
#endif
}
```

```cpp
#include <hip/hip_runtime.h>
#include <cstdio>
#include <cstdint>
namespace pg8 {
#define PG8_LAS __attribute__((address_space(3)))
typedef unsigned short bf16_t;
typedef short bf16x8 __attribute__((ext_vector_type(8)));
typedef float f32x4 __attribute__((ext_vector_type(4)));
typedef unsigned u32x4 __attribute__((ext_vector_type(4)));
constexpr int BM = 256, BK = 64, HALF = 128, HTB = HALF * BK * 2  , STAGE_BYTES = 8 * HTB, NXCD = 8, WGM = 8;

__host__ __device__ __forceinline__ int lds_byte(int r, int c) { const int st = (r >> 4) * 2 + (c >> 5), rr = r & 15, cc = c & 31, ob = rr * 64 + cc * 2; return st * 1024 + (ob ^ (((ob >> 9) & 1) << 5)); }
__host__ __device__ __forceinline__ void stage_rc(int b, int& R, int& C) { const int st = b / 1024, sb = b % 1024, swz = sb ^ (((sb >> 9) & 1) << 5); R = (st >> 1) * 16 + swz / 64; C = (st & 1) * 32 + (swz % 64) / 2; }
__host__ __device__ __forceinline__ int perm32(int rho) { const int n = rho >> 4, i = rho & 15; return 8 * (i >> 2) + 4 * n + (i & 3); }

struct Unit { int pm, pn; };
struct Gemm { const bf16_t* A; const bf16_t* Bt; int M, N, K; };

struct StaticOrder {
    int nM, nN, nwg, G, c, i0 = 0, cnt = 1 << 30;
    __host__ __device__ void init(int M, int N, int G_, int c_) { nM = M / BM; nN = N / BM; nwg = nM * nN; G = G_; c = c_; }
    __host__ __device__ bool next(int i, Unit& u) const {
        if (i >= cnt) return false;
        const long L = (long)(i + i0) * G + c; if (L >= nwg) return false;
        int wgid = (int)L; { const int q = nwg / NXCD, r = nwg % NXCD, xcd = wgid % NXCD, off = wgid / NXCD; wgid = (xcd < r ? xcd * (q + 1) : r * (q + 1) + (xcd - r) * q) + off; }
        const int nig = WGM * nN, gid = wgid / nig, fm = gid * WGM, gsz = (nM - fm) < WGM ? (nM - fm) : WGM;
        u.pm = fm + ((wgid % nig) % gsz); u.pn = (wgid % nig) / gsz; return true;
    }
    __device__ __forceinline__ void a_ready(const Unit&) const {}
    __device__ __forceinline__ void done(const Unit&) const {}
};

__device__ __forceinline__ unsigned cvt_pk_bf16(float lo, float hi) { unsigned r; asm volatile("v_cvt_pk_bf16_f32 %0, %1, %2" : "=v"(r) : "v"(lo), "v"(hi)); return r; }
__device__ __forceinline__ float bf_lo(unsigned w) { return __builtin_bit_cast(float, w << 16); }
__device__ __forceinline__ float bf_hi(unsigned w) { return __builtin_bit_cast(float, w & 0xffff0000u); }
__device__ __forceinline__ float sigmoidf_fast(float x) { return __builtin_amdgcn_rcpf(1.0f + __builtin_amdgcn_exp2f(x * -1.44269504089f)); }
__device__ __forceinline__ float row_rs(const float* ssq, int row) {
    const f32x4* p = (const f32x4*)(ssq + (size_t)row * 16);
    const f32x4 a = p[0], b = p[1], c = p[2], d = p[3];
    const f32x4 s = (a + b) + (c + d);
    return __builtin_amdgcn_rsqf(((s[0] + s[1]) + (s[2] + s[3])) * (1.0f / 1024.0f) + 1e-6f);
}

__device__ __forceinline__ void row_rs8(const float* ssq, int row0, int fq, float (&rs)[2][4]) {
    f32x4 q[2][4];
#pragma unroll
    for (int ai = 0; ai < 2; ++ai)
#pragma unroll
        for (int m = 0; m < 4; ++m) q[ai][m] = *(const f32x4*)(ssq + (size_t)(row0 + ai * HALF + m * 16) * 16 + 4 * fq);
#pragma unroll
    for (int ai = 0; ai < 2; ++ai)
#pragma unroll
        for (int m = 0; m < 4; ++m) { float t = (q[ai][m][0] + q[ai][m][1]) + (q[ai][m][2] + q[ai][m][3]); t += __shfl_xor(t, 16); t += __shfl_xor(t, 32);
            rs[ai][m] = __builtin_amdgcn_rsqf(t * (1.0f / 1024.0f) + 1e-6f); }
}

struct EpiPlain {
    static constexpr bool PERM = true, AFTER_DRAIN = false;
    bf16_t* O; int ldc;
    __device__ __forceinline__ void operator()(const f32x4 (&acc)[2][2][4][2], const Unit& u, int wr, int wc, int fr, int fq) const {
        const int row0 = u.pm * BM + wr * 64 + fr, col0 = u.pn * BM + wc * 32 + 8 * fq;
#pragma unroll
        for (int ai = 0; ai < 2; ++ai)
#pragma unroll
            for (int m = 0; m < 4; ++m) { bf16_t* rowp = O + (size_t)(row0 + ai * HALF + m * 16) * ldc + col0;
#pragma unroll
                for (int bj = 0; bj < 2; ++bj) { const f32x4 v0 = acc[ai][bj][m][0], v1 = acc[ai][bj][m][1];
                    u32x4 w; w.x = cvt_pk_bf16(v0[0], v0[1]); w.y = cvt_pk_bf16(v0[2], v0[3]); w.z = cvt_pk_bf16(v1[0], v1[1]); w.w = cvt_pk_bf16(v1[2], v1[3]);
                    *(u32x4*)(rowp + bj * HALF) = w; } }
    }
};
struct EpiProj {
    static constexpr bool PERM = true, AFTER_DRAIN = false;
    bf16_t* O; int ldc; const float* ssq;
    __device__ __forceinline__ void operator()(const f32x4 (&acc)[2][2][4][2], const Unit& u, int wr, int wc, int fr, int fq) const {
        const int row0 = u.pm * BM + wr * 64 + fr, col0 = u.pn * BM + wc * 32 + 8 * fq;
#pragma unroll
        for (int ai = 0; ai < 2; ++ai)
#pragma unroll
            for (int m = 0; m < 4; ++m) { const int row = row0 + ai * HALF + m * 16; const float rs = row_rs(ssq, row); bf16_t* rowp = O + (size_t)row * ldc + col0;
#pragma unroll
                for (int bj = 0; bj < 2; ++bj) { const f32x4 v0 = acc[ai][bj][m][0] * rs, v1 = acc[ai][bj][m][1] * rs;
                    u32x4 w; w.x = cvt_pk_bf16(v0[0], v0[1]); w.y = cvt_pk_bf16(v0[2], v0[3]); w.z = cvt_pk_bf16(v1[0], v1[1]); w.w = cvt_pk_bf16(v1[2], v1[3]);
                    *(u32x4*)(rowp + bj * HALF) = w; } }
    }
};
template <int CTRL> __device__ __forceinline__ float dpp_mov(float old, float src) {
    return __builtin_bit_cast(float, __builtin_amdgcn_update_dpp(__builtin_bit_cast(int, old), __builtin_bit_cast(int, src), CTRL, 0xf, 0xf, false)); }
constexpr int DPP_SHR = 0x110, DPP_ROR = 0x120;
template <int S> __device__ __forceinline__ float row_up(float cur, float prev) { return dpp_mov<DPP_SHR + S>(dpp_mov<DPP_ROR + S>(0.f, prev), cur); }

struct EpiConvA {
    static constexpr bool PERM = true, AFTER_DRAIN = false;
    bf16_t* G; const float* ssq; const float* wconv; float* cvbuf; float* gbuf;
    __device__ __forceinline__ void operator()(const f32x4 (&acc)[2][2][4][2], const Unit& u, int wr, int wc, int fr, int fq) const {
        const int e0 = u.pn * 64 + wc * 16 + fq * 4, row0 = u.pm * BM + wr * 64 + fr;
        const f32x4 w0 = *(const f32x4*)(wconv + e0), w1 = *(const f32x4*)(wconv + 1024 + e0), w2 = *(const f32x4*)(wconv + 2048 + e0);
        float rsv[2][4]; row_rs8(ssq, row0, fq, rsv);
#pragma unroll
        for (int ai = 0; ai < 2; ++ai) {
            f32x4 cvp = (f32x4){0.f, 0.f, 0.f, 0.f};
#pragma unroll
            for (int m = 0; m < 4; ++m) { const int row = row0 + ai * HALF + m * 16; const float rs = rsv[ai][m];
                const f32x4 b = acc[ai][0][m][0] * rs, z = acc[ai][1][m][1] * rs, cv = (acc[ai][0][m][1] * rs) * (acc[ai][1][m][0] * rs);
                f32x4 gb, y;
#pragma unroll
                for (int j = 0; j < 4; ++j) { const float s1 = row_up<1>(cv[j], cvp[j]), s2 = row_up<2>(cv[j], cvp[j]);
                    gb[j] = z[j] * sigmoidf_fast(z[j]) * b[j]; y[j] = gb[j] * (w0[j] * s2 + w1[j] * s1 + w2[j] * cv[j]); }
                typedef unsigned u32x2 __attribute__((ext_vector_type(2)));
                u32x2 o; o.x = cvt_pk_bf16(y[0], y[1]); o.y = cvt_pk_bf16(y[2], y[3]);
                *(u32x2*)(G + (size_t)row * 1024 + e0) = o;
                if (m == 0 && fr < 2) *(f32x4*)(gbuf + ((size_t)(row >> 6) * 2 + fr) * 1024 + e0) = gb;
                if (m == 3 && fr >= 14) *(f32x4*)(cvbuf + ((size_t)(row >> 6) * 2 + (fr - 14)) * 1024 + e0) = cv;
                cvp = cv; }
        }
    }
};
struct EpiPoolB {
    static constexpr bool PERM = true, AFTER_DRAIN = false;
    bf16_t* G; const float* ssq; const float* scale; float* hbuf; float* fbuf;
    template <int S> static __device__ __forceinline__ void step(f32x4 (&W)[4]) {
#pragma unroll
        for (int m = 3; m >= 0; --m)
#pragma unroll
            for (int j = 0; j < 4; ++j) W[m][j] += row_up<S>(W[m][j], m ? W[m - 1][j] : 0.f);
    }
    __device__ __forceinline__ void operator()(const f32x4 (&acc)[2][2][4][2], const Unit& u, int wr, int wc, int fr, int fq) const {
        const int ch0 = u.pn * 128 + wc * 32 + fq * 8, g = u.pn >> 1, w = 2 << g, row0 = u.pm * BM + wr * 64 + fr;
        typedef unsigned u32x2 __attribute__((ext_vector_type(2)));
        float rsv[2][4]; row_rs8(ssq, row0, fq, rsv);
        const f32x4 scv[2] = {*(const f32x4*)(scale + ch0), *(const f32x4*)(scale + ch0 + 4)};
#pragma unroll
        for (int ai = 0; ai < 2; ++ai) {
            float rs[4];
#pragma unroll
            for (int m = 0; m < 4; ++m) rs[m] = rsv[ai][m];
            u32x2 res[2][4];
#pragma unroll
            for (int n = 0; n < 2; ++n) {
                const f32x4 sc = scv[n];
                f32x4 W[4];
#pragma unroll
                for (int m = 0; m < 4; ++m) W[m] = acc[ai][0][m][n] * rs[m];
                step<1>(W); if (g >= 1) step<2>(W); if (g >= 2) step<4>(W); if (g >= 3) step<8>(W);
#pragma unroll
                for (int m = 0; m < 4; ++m) { const int row = row0 + ai * HALF + m * 16, tt = row & 4095; const int cnt = (tt + 1) < w ? (tt + 1) : w; const float inv = __builtin_amdgcn_rcpf((float)cnt);
                    const f32x4 uu = acc[ai][0][m][n] * rs[m], zz = acc[ai][1][m][n] * rs[m]; f32x4 fz, o;
#pragma unroll
                    for (int j = 0; j < 4; ++j) { fz[j] = zz[j] * sigmoidf_fast(zz[j]) * sc[j]; o[j] = fz[j] * (W[m][j] * inv - uu[j]); }
                    res[n][m].x = cvt_pk_bf16(o[0], o[1]); res[n][m].y = cvt_pk_bf16(o[2], o[3]);
                    if (m == 0 && fr < 15) *(f32x4*)(fbuf + ((size_t)(row >> 6) * 15 + fr) * 1024 + ch0 + 4 * n) = fz * inv;
                    if (m == 3 && fr >= 1) *(f32x4*)(hbuf + ((size_t)(row >> 6) * 15 + (fr - 1)) * 1024 + ch0 + 4 * n) = uu; }
            }
#pragma unroll
            for (int m = 0; m < 4; ++m) { u32x4 o; o.x = res[0][m].x; o.y = res[0][m].y; o.z = res[1][m].x; o.w = res[1][m].y;
                *(u32x4*)(G + (size_t)(row0 + ai * HALF + m * 16) * 1024 + ch0) = o; }
        }
    }
};
struct EpiNull {
    static constexpr bool PERM = true, AFTER_DRAIN = false;
    float* O;
    __device__ __forceinline__ void operator()(const f32x4 (&acc)[2][2][4][2], const Unit& u, int wr, int wc, int fr, int fq) const {
        float s = 0.f;
#pragma unroll
        for (int ai = 0; ai < 2; ++ai)
#pragma unroll
            for (int bj = 0; bj < 2; ++bj)
#pragma unroll
                for (int m = 0; m < 4; ++m)
#pragma unroll
                    for (int n = 0; n < 2; ++n) s += (acc[ai][bj][m][n][0] + acc[ai][bj][m][n][1]) + (acc[ai][bj][m][n][2] + acc[ai][bj][m][n][3]);
        if (s == 12345.678f) O[u.pm] = s;
    }
};
struct EpiPP {
    static constexpr bool PERM = true, AFTER_DRAIN = false;
    bf16_t* O;
    __device__ __forceinline__ void operator()(const f32x4 (&acc)[2][2][4][2], const Unit& u, int wr, int wc, int fr, int fq) const {
        const int row0 = u.pm * BM + wr * 64 + fr, col0 = (u.pn & 3) * BM + wc * 32 + 8 * fq;
#pragma unroll
        for (int ai = 0; ai < 2; ++ai)
#pragma unroll
            for (int m = 0; m < 4; ++m) { bf16_t* rowp = O + (size_t)(row0 + ai * HALF + m * 16) * 1024 + col0;
#pragma unroll
                for (int bj = 0; bj < 2; ++bj) { const f32x4 v0 = acc[ai][bj][m][0], v1 = acc[ai][bj][m][1];
                    u32x4 w; w.x = cvt_pk_bf16(v0[0], v0[1]); w.y = cvt_pk_bf16(v0[2], v0[3]); w.z = cvt_pk_bf16(v1[0], v1[1]); w.w = cvt_pk_bf16(v1[2], v1[3]);
                    *(u32x4*)(rowp + bj * HALF) = w; } }
    }
};
struct EpiResid {
    static constexpr bool PERM = true, AFTER_DRAIN = false;
    const bf16_t* Hin; bf16_t* Hb; float* ssq_out;
    __device__ __forceinline__ void operator()(const f32x4 (&acc)[2][2][4][2], const Unit& u, int wr, int wc, int fr, int fq) const {
        const int row0 = u.pm * BM + wr * 64 + fr, col0 = u.pn * BM + wc * 32 + 8 * fq;
#pragma unroll
        for (int ai = 0; ai < 2; ++ai) {
            u32x4 hw[4][2];
#pragma unroll
            for (int m = 0; m < 4; ++m)
#pragma unroll
                for (int bj = 0; bj < 2; ++bj) hw[m][bj] = *(const u32x4*)(Hin + (size_t)(row0 + ai * HALF + m * 16) * 1024 + col0 + bj * HALF);
#pragma unroll
            for (int m = 0; m < 4; ++m) { const int row = row0 + ai * HALF + m * 16; const size_t off = (size_t)row * 1024 + col0; float s = 0.f;
#pragma unroll
                for (int bj = 0; bj < 2; ++bj) {
                    const u32x4 h = hw[m][bj];
                    f32x4 v0 = acc[ai][bj][m][0], v1 = acc[ai][bj][m][1];
                    v0[0] += bf_lo(h.x); v0[1] += bf_hi(h.x); v0[2] += bf_lo(h.y); v0[3] += bf_hi(h.y);
                    v1[0] += bf_lo(h.z); v1[1] += bf_hi(h.z); v1[2] += bf_lo(h.w); v1[3] += bf_hi(h.w);
                    u32x4 w; w.x = cvt_pk_bf16(v0[0], v0[1]); w.y = cvt_pk_bf16(v0[2], v0[3]); w.z = cvt_pk_bf16(v1[0], v1[1]); w.w = cvt_pk_bf16(v1[2], v1[3]);
                    *(u32x4*)(Hb + off + bj * HALF) = w;
                    s += ((v0[0] * v0[0] + v0[1] * v0[1]) + (v0[2] * v0[2] + v0[3] * v0[3])) + ((v1[0] * v1[0] + v1[1] * v1[1]) + (v1[2] * v1[2] + v1[3] * v1[3])); }
                s += __shfl_xor(s, 16); s += __shfl_xor(s, 32);
                if (fq == 0) ssq_out[(size_t)row * 16 + u.pn * 4 + wc] = s; }
        }
    }
};
struct EpiPle {
    static constexpr bool PERM = true, AFTER_DRAIN = false;
    const bf16_t* Hin; bf16_t* Hb; const bf16_t* PP; const float* ssq_in; float* ssq_out;
    __device__ __forceinline__ void operator()(const f32x4 (&acc)[2][2][4][2], const Unit& u, int wr, int wc, int fr, int fq) const {
        const int row0 = u.pm * BM + wr * 64 + fr, col0 = u.pn * BM + wc * 32 + 8 * fq;
        float rsv[2][4]; row_rs8(ssq_in, row0, fq, rsv);
#pragma unroll
        for (int am = 0; am < 4; ++am) { const int ai = am >> 1;
            u32x4 hw[4][2], pw[4][2];
#pragma unroll
            for (int m = 2 * (am & 1); m < 2 * (am & 1) + 2; ++m)
#pragma unroll
                for (int bj = 0; bj < 2; ++bj) { const size_t o = (size_t)(row0 + ai * HALF + m * 16) * 1024 + col0 + bj * HALF; hw[m][bj] = *(const u32x4*)(Hin + o); pw[m][bj] = *(const u32x4*)(PP + o); }
#pragma unroll
            for (int m = 2 * (am & 1); m < 2 * (am & 1) + 2; ++m) { const int row = row0 + ai * HALF + m * 16; const size_t off = (size_t)row * 1024 + col0; float s = 0.f; const float rs = rsv[ai][m];
#pragma unroll
                for (int bj = 0; bj < 2; ++bj) {
                    const u32x4 p = pw[m][bj], h = hw[m][bj];
                    const f32x4 a0 = acc[ai][bj][m][0] * rs, a1 = acc[ai][bj][m][1] * rs;
                    f32x4 v0, v1;
                    v0[0] = bf_lo(h.x) + sigmoidf_fast(a0[0]) * bf_lo(p.x); v0[1] = bf_hi(h.x) + sigmoidf_fast(a0[1]) * bf_hi(p.x);
                    v0[2] = bf_lo(h.y) + sigmoidf_fast(a0[2]) * bf_lo(p.y); v0[3] = bf_hi(h.y) + sigmoidf_fast(a0[3]) * bf_hi(p.y);
                    v1[0] = bf_lo(h.z) + sigmoidf_fast(a1[0]) * bf_lo(p.z); v1[1] = bf_hi(h.z) + sigmoidf_fast(a1[1]) * bf_hi(p.z);
                    v1[2] = bf_lo(h.w) + sigmoidf_fast(a1[2]) * bf_lo(p.w); v1[3] = bf_hi(h.w) + sigmoidf_fast(a1[3]) * bf_hi(p.w);
                    u32x4 w; w.x = cvt_pk_bf16(v0[0], v0[1]); w.y = cvt_pk_bf16(v0[2], v0[3]); w.z = cvt_pk_bf16(v1[0], v1[1]); w.w = cvt_pk_bf16(v1[2], v1[3]);
                    *(u32x4*)(Hb + off + bj * HALF) = w;
                    s += ((v0[0] * v0[0] + v0[1] * v0[1]) + (v0[2] * v0[2] + v0[3] * v0[3])) + ((v1[0] * v1[0] + v1[1] * v1[1]) + (v1[2] * v1[2] + v1[3] * v1[3])); }
                s += __shfl_xor(s, 16); s += __shfl_xor(s, 32);
                if (fq == 0) ssq_out[(size_t)row * 16 + u.pn * 4 + wc] = s; }
        }
    }
};
struct PPOrder {
    StaticOrder so;
    __device__ void init(int G_, int c_) { so.init(32768, 1024, G_, 0); so.G = G_; so.c = c_; }
    __device__ bool next(int i, Unit& u) const {
        const long L = (long)i * so.G + so.c; if (L >= 2048) return false;
        const int layer = (int)(L >> 9), Ll = (int)(L & 511);
        StaticOrder t = so; t.G = 512; t.c = Ll; Unit v; t.next(0, v);
        u.pm = layer * 128 + v.pm; u.pn = layer * 4 + v.pn; return true;
    }
    __device__ __forceinline__ void a_ready(const Unit&) const {}
    __device__ __forceinline__ void done(const Unit&) const {}
};
template <class Epi, class Sched, bool ALIGN_EPI = false, bool SP2 = false>
__device__ __forceinline__ void gemm_phase(PG8_LAS unsigned char* lds, const Gemm g, const Sched& S, const Epi& E) {
    int tid_o = threadIdx.x; asm volatile("" : "+v"(tid_o));
    const int tid = tid_o, wid = __builtin_amdgcn_readfirstlane(tid >> 6), lane = tid & 63, wr = wid >> 2, wc = wid & 3, fr = lane & 15, fq = lane >> 4;
    const int K = g.K, nt = K / BK;
    unsigned voffA[2], voffB[2];
#pragma unroll
    for (int i = 0; i < 2; ++i) { int R, C; stage_rc(tid * 16 + i * 8192, R, C); const int Rb = Epi::PERM ? ((R & ~31) + perm32(R & 31)) : R;
        voffA[i] = (unsigned)(R * K + C) * 2u; voffB[i] = (unsigned)(Rb * K + C) * 2u; }
    const size_t kstep = (size_t)(BK * 2);
    const size_t hstep = (size_t)HALF * K * 2;
    const size_t tstep = 2 * hstep;
    const unsigned ldsw = (unsigned)wid * 1024u;
    const int aoff = lds_byte(wr * 64 + fr, fq * 8), boff = lds_byte(wc * 32 + fr, fq * 8);
#define PG8_SA(b, h) (((b) * 2 + (h)) * HTB)
#define PG8_SB(b, h) ((4 + (b) * 2 + (h)) * HTB)
#define PG8_STAGE(bufoff, gbase, voff) do { _Pragma("unroll") for (int _i = 0; _i < 2; ++_i) \
        __builtin_amdgcn_global_load_lds((const unsigned*)((const char*)(gbase) + (voff)[_i]), (PG8_LAS unsigned*)(lds + (bufoff) + ldsw + _i * 8192), 16, 0, 0); } while (0)
#define PG8_LDA(dst, b, h) do { _Pragma("unroll") for (int m = 0; m < 4; ++m) _Pragma("unroll") for (int k = 0; k < 2; ++k) dst[m][k] = *(const PG8_LAS bf16x8*)(lds + PG8_SA(b, h) + aoff + m * 2048 + k * 1024); } while (0)
#define PG8_LDB(dst, b, h) do { _Pragma("unroll") for (int n = 0; n < 2; ++n) _Pragma("unroll") for (int k = 0; k < 2; ++k) dst[n][k] = *(const PG8_LAS bf16x8*)(lds + PG8_SB(b, h) + boff + n * 2048 + k * 1024); } while (0)
#define PG8_MMA(ai, bj, At, Bt) do { __builtin_amdgcn_s_setprio(1); _Pragma("unroll") for (int m = 0; m < 4; ++m) _Pragma("unroll") for (int n = 0; n < 2; ++n) _Pragma("unroll") for (int k = 0; k < 2; ++k) \
        acc[ai][bj][m][n] = __builtin_amdgcn_mfma_f32_16x16x32_bf16(Bt[n][k], At[m][k], acc[ai][bj][m][n], 0, 0, 0); __builtin_amdgcn_s_setprio(0); } while (0)
#define PG8_WAIT_V(n) asm volatile("s_waitcnt vmcnt(" #n ")" ::: "memory")
#define PG8_WAIT_L(n) asm volatile("s_waitcnt lgkmcnt(" #n ")" ::: "memory")
#define PG8_BAR __builtin_amdgcn_s_barrier()
#define PG8_SCHED __builtin_amdgcn_sched_barrier(0)
    Unit cur, nxt; int ui = 0;
    if (!S.next(0, cur)) return;
    f32x4 acc[2][2][4][2];
#pragma unroll
    for (int a = 0; a < 2; ++a)
#pragma unroll
        for (int b = 0; b < 2; ++b)
#pragma unroll
            for (int m = 0; m < 4; ++m)
#pragma unroll
                for (int n = 0; n < 2; ++n) acc[a][b][m][n] = (f32x4){0.f, 0.f, 0.f, 0.f};
    bf16x8 At[4][2], B0[2][2], B1[2][2];
    const char* cA = (const char*)g.A + (size_t)cur.pm * tstep; const char* cB = (const char*)g.Bt + (size_t)cur.pn * tstep;
    S.a_ready(cur);
    if constexpr (SP2) {
        PG8_STAGE(PG8_SB(0, 0), cB, voffB); PG8_STAGE(PG8_SB(0, 1), cB + hstep, voffB); PG8_STAGE(PG8_SA(0, 0), cA, voffA); PG8_STAGE(PG8_SA(0, 1), cA + hstep, voffA);
        if (wr == 1) PG8_BAR;
        PG8_WAIT_V(2); PG8_BAR;
        PG8_STAGE(PG8_SB(1, 0), cB + kstep, voffB); PG8_STAGE(PG8_SA(1, 0), cA + kstep, voffA); PG8_STAGE(PG8_SB(1, 1), cB + hstep + kstep, voffB);
        PG8_WAIT_V(6); PG8_BAR;
    } else {
        PG8_STAGE(PG8_SB(0, 0), cB, voffB); PG8_STAGE(PG8_SA(0, 0), cA, voffA); PG8_STAGE(PG8_SB(0, 1), cB + hstep, voffB); PG8_STAGE(PG8_SA(0, 1), cA + hstep, voffA);
        if (wr == 1) PG8_BAR;
        PG8_WAIT_V(4); PG8_BAR;
        PG8_STAGE(PG8_SB(1, 0), cB + kstep, voffB); PG8_STAGE(PG8_SA(1, 0), cA + kstep, voffA); PG8_STAGE(PG8_SB(1, 1), cB + hstep + kstep, voffB);
        PG8_WAIT_V(6); PG8_BAR;
    }
    for (;;) {
        const bool has_next = S.next(ui + 1, nxt);
        const char* nA = has_next ? (const char*)g.A + (size_t)nxt.pm * tstep : cA; const char* nB = has_next ? (const char*)g.Bt + (size_t)nxt.pn * tstep : cB;
        _Pragma("nounroll") for (int t = 0; t < nt; t += 2) {
            const bool last = (t == nt - 2);
            const char* a1 = cA + (size_t)(t + 1) * kstep;
            const char* a2 = last ? nA : cA + (size_t)(t + 2) * kstep; const char* b2 = last ? nB : cB + (size_t)(t + 2) * kstep;
            const char* a3 = a2 + kstep; const char* b3 = b2 + kstep;
            if (last && has_next) S.a_ready(nxt);
            if constexpr (SP2) {
            PG8_LDB(B0, 0, 0); PG8_LDB(B1, 0, 1); PG8_SCHED; PG8_LDA(At, 0, 0); PG8_STAGE(PG8_SA(1, 1), a1 + hstep, voffA);
            PG8_WAIT_V(8); PG8_WAIT_L(0); PG8_BAR; PG8_MMA(0, 0, At, B0); PG8_MMA(0, 1, At, B1); PG8_BAR; PG8_SCHED;
            PG8_LDA(At, 0, 1); PG8_STAGE(PG8_SB(0, 0), b2, voffB); PG8_STAGE(PG8_SB(0, 1), b2 + hstep, voffB); PG8_STAGE(PG8_SA(0, 0), a2, voffA);
            PG8_WAIT_V(8); PG8_WAIT_L(0); PG8_BAR; PG8_MMA(1, 0, At, B0); PG8_MMA(1, 1, At, B1); PG8_BAR; PG8_SCHED;
            PG8_LDB(B0, 1, 0); PG8_LDB(B1, 1, 1); PG8_SCHED; PG8_LDA(At, 1, 0); PG8_STAGE(PG8_SA(0, 1), a2 + hstep, voffA);
            PG8_WAIT_V(8); PG8_WAIT_L(0); PG8_BAR; PG8_MMA(0, 0, At, B0); PG8_MMA(0, 1, At, B1); PG8_BAR; PG8_SCHED;
            PG8_LDA(At, 1, 1); PG8_STAGE(PG8_SB(1, 0), b3, voffB); PG8_STAGE(PG8_SB(1, 1), b3 + hstep, voffB); PG8_STAGE(PG8_SA(1, 0), a3, voffA);
            PG8_WAIT_V(8); PG8_WAIT_L(0); PG8_BAR; PG8_MMA(1, 0, At, B0); PG8_MMA(1, 1, At, B1); PG8_BAR; PG8_SCHED;
            } else {
            PG8_LDB(B0, 0, 0); PG8_SCHED; PG8_LDA(At, 0, 0); PG8_STAGE(PG8_SA(1, 1), a1 + hstep, voffA);
            PG8_WAIT_L(8); PG8_BAR; PG8_WAIT_L(0); PG8_MMA(0, 0, At, B0); PG8_BAR; PG8_SCHED;
            PG8_LDB(B1, 0, 1); PG8_STAGE(PG8_SB(0, 0), b2, voffB);
            PG8_BAR; PG8_WAIT_L(0); PG8_MMA(0, 1, At, B1); PG8_BAR;
            PG8_LDA(At, 0, 1); PG8_STAGE(PG8_SA(0, 0), a2, voffA);
            PG8_BAR; PG8_WAIT_L(0); PG8_MMA(1, 0, At, B0); PG8_BAR; PG8_SCHED;
            PG8_STAGE(PG8_SB(0, 1), b2 + hstep, voffB);
            PG8_WAIT_V(6); PG8_BAR; PG8_MMA(1, 1, At, B1); PG8_BAR;
            PG8_LDB(B0, 1, 0); PG8_SCHED; PG8_LDA(At, 1, 0); PG8_STAGE(PG8_SA(0, 1), a2 + hstep, voffA);
            PG8_WAIT_L(8); PG8_BAR; PG8_WAIT_L(0); PG8_MMA(0, 0, At, B0); PG8_BAR; PG8_SCHED;
            PG8_LDB(B1, 1, 1); PG8_STAGE(PG8_SB(1, 0), b3, voffB);
            PG8_BAR; PG8_WAIT_L(0); PG8_MMA(0, 1, At, B1); PG8_BAR;
            PG8_LDA(At, 1, 1); PG8_STAGE(PG8_SA(1, 0), a3, voffA);
            PG8_BAR; PG8_WAIT_L(0); PG8_MMA(1, 0, At, B0); PG8_BAR; PG8_SCHED;
            PG8_STAGE(PG8_SB(1, 1), b3 + hstep, voffB);
            PG8_WAIT_V(6); PG8_BAR; PG8_MMA(1, 1, At, B1); PG8_BAR;
            }
        }
        if constexpr (ALIGN_EPI) { if (wr == 0) PG8_BAR; }
        if constexpr (!Epi::AFTER_DRAIN) { E(acc, cur, wr, wc, fr, fq); S.done(cur); }
        if (!has_next) break;
#pragma unroll
        for (int a = 0; a < 2; ++a)
#pragma unroll
            for (int b = 0; b < 2; ++b)
#pragma unroll
                for (int m = 0; m < 4; ++m)
#pragma unroll
                    for (int n = 0; n < 2; ++n) acc[a][b][m][n] = (f32x4){0.f, 0.f, 0.f, 0.f};
        cur = nxt; cA = nA; cB = nB; ++ui;
        if constexpr (ALIGN_EPI) { if (wr == 1) PG8_BAR; }
    }
    PG8_WAIT_V(0);
    if constexpr (!ALIGN_EPI) { if (wr == 0) PG8_BAR; }
    PG8_BAR;
    if constexpr (Epi::AFTER_DRAIN) { E.fused(acc, cur, wr, wc, fr, fq, lds, wid, lane); S.done(cur); }
#undef PG8_SA
#undef PG8_SB
#undef PG8_STAGE
#undef PG8_LDA
#undef PG8_LDB
#undef PG8_MMA
#undef PG8_WAIT_V
#undef PG8_WAIT_L
#undef PG8_BAR
#undef PG8_SCHED
}
}
#define GAS __attribute__((address_space(1)))
#define LAS __attribute__((address_space(3)))
typedef unsigned short bf16;
typedef unsigned v4u __attribute__((ext_vector_type(4)));
typedef float f32x4 __attribute__((ext_vector_type(4)));
typedef short bf16x8 __attribute__((ext_vector_type(8)));
typedef GAS unsigned gu32;
typedef GAS unsigned long long gu64;
#define RLX_AGENT __ATOMIC_RELAXED, __HIP_MEMORY_SCOPE_AGENT
#define LDS_WAIT() asm volatile("s_waitcnt lgkmcnt(0)" ::: "memory")
#define VM_WAIT() asm volatile("s_waitcnt vmcnt(0)" ::: "memory")
__device__ __forceinline__ unsigned long long rt() { return __builtin_amdgcn_s_memrealtime(); }
__device__ __forceinline__ unsigned f2bf(float f) { unsigned u = __builtin_bit_cast(unsigned, f); return (u + 0x7fffu + ((u >> 16) & 1u)) >> 16; }
__device__ __forceinline__ unsigned pk2(float lo, float hi) { return f2bf(lo) | (f2bf(hi) << 16); }

#define XB_TMO      128
#define XB_XCNT(j)  (256  + 64 * (j))
#define XB_XSUB(j)  (1280 + 64 * (j))
#define XB_XGEN(j)  (2304 + 64 * (j))
#define XB_TOP      3328
#define XB_TOPGEN   3392
#define XCD_BAR_WORDS 3456
#define XB_SPIN_CAP (1u << 18)

__device__ __forceinline__ unsigned xb_ld(unsigned* p)              { return __hip_atomic_load(p, __ATOMIC_RELAXED, __HIP_MEMORY_SCOPE_AGENT); }
__device__ __forceinline__ unsigned xb_add(unsigned* p, unsigned v) { return __hip_atomic_fetch_add(p, v, __ATOMIC_RELAXED, __HIP_MEMORY_SCOPE_AGENT); }
__device__ __forceinline__ unsigned xb_xcc_id() { return (unsigned)__builtin_amdgcn_s_getreg((3 << 11) | 20) & 0xFu; }
#define XB_SPIN(cond, bar) do { unsigned _sp = 0; while (cond) { __builtin_amdgcn_s_sleep(1); \
    if ((++_sp & 255u) == 0u) { if (xb_ld(&(bar)[XB_TMO])) break; if (_sp > XB_SPIN_CAP) { atomicAdd(&(bar)[XB_TMO], 1u); break; } } } } while (0)

struct XcdBarrier {
    unsigned* bar; unsigned x;
    volatile LAS unsigned* st;
};

__device__ __forceinline__ XcdBarrier xcd_barrier_post(unsigned* bar, volatile LAS unsigned* st) {
    XcdBarrier b; b.bar = bar; b.x = xb_xcc_id(); b.st = st;
    if (threadIdx.x == 0) (void)xb_add(&bar[XB_XCNT(b.x)], 1u);
    return b;
}
__device__ __forceinline__ void xcd_barrier_complete(unsigned* bar, unsigned x, unsigned& nloc, unsigned& nx) {
    const unsigned G = gridDim.x * gridDim.y * gridDim.z;
    unsigned sum, cnt, mine, sp = 0u;
    for (;;) {
        sum = 0u; cnt = 0u; mine = 0u;
#pragma unroll
        for (unsigned j = 0; j < 16; ++j) { const unsigned c = xb_ld(&bar[XB_XCNT(j)]); sum += c; cnt += (c > 0u) ? 1u : 0u; mine = (j == x) ? c : mine; }
        if (sum == G) break;
        __builtin_amdgcn_s_sleep(1);
        if ((++sp & 255u) == 0u) { if (xb_ld(&bar[XB_TMO])) break; if (sp > XB_SPIN_CAP) { atomicAdd(&bar[XB_TMO], 1u); break; } }
    }
    nloc = mine > 0u ? mine : 1u; nx = cnt > 0u ? cnt : 1u;
}

__device__ __forceinline__ void xcd_barrier(const XcdBarrier& b) {
    asm volatile("s_waitcnt vmcnt(0)" ::: "memory");
    __syncthreads();
    if (threadIdx.x == 0) {
        unsigned* bar = b.bar;
        __builtin_amdgcn_s_waitcnt(0);
        unsigned nloc = b.st[0], nx = b.st[1];
        if (nloc == 0u) { xcd_barrier_complete(bar, b.x, nloc, nx); b.st[0] = nloc; b.st[1] = nx; }
        const unsigned old = xb_add(&bar[XB_XSUB(b.x)], 1u);
        const unsigned gen = old / nloc;
        if (old + 1u == (gen + 1u) * nloc) {
            __builtin_amdgcn_fence(__ATOMIC_RELEASE, "agent");
            asm volatile("s_waitcnt vmcnt(0)" ::: "memory");
            const unsigned og = xb_add(&bar[XB_TOP], 1u);
            const unsigned tg = og / nx;
            if (og + 1u == (tg + 1u) * nx) xb_add(&bar[XB_TOPGEN], 1u);
            else XB_SPIN(xb_ld(&bar[XB_TOPGEN]) == tg, bar);
            __builtin_amdgcn_fence(__ATOMIC_ACQUIRE, "agent");
            xb_add(&bar[XB_XGEN(b.x)], 1u);
            asm volatile("s_waitcnt vmcnt(0)" ::: "memory");
        } else {
            XB_SPIN(xb_ld(&bar[XB_XGEN(b.x)]) == gen, bar);
            __builtin_amdgcn_fence(__ATOMIC_ACQUIRE, "agent");
            asm volatile("s_waitcnt vmcnt(0)" ::: "memory");
        }
    }
    __syncthreads();
}
using pg8::bf_lo; using pg8::bf_hi;

constexpr int NWAVES = 8;
constexpr int M = 32768, D = 1024, SEQ = 4096, DEPTH = 4, PLE = 256;
constexpr float EPS = 1e-6f;
#ifndef EN_MASK
#define EN_MASK 0xff
#endif
#ifndef PROBE_REP
#define PROBE_REP 0
#endif
#define REP(k) for (int rep_ = 0; rep_ < ((PROBE_REP & (k)) ? 2 : 1); ++rep_)
#ifndef MK_MULTI
#define MK_MULTI 0
#endif
constexpr size_t MiB = 1u << 20;
constexpr size_t WS_CTL = 0, CTL_ZERO_BYTES = 1 * MiB;
constexpr size_t WS_WAIN = 2 * MiB;
constexpr size_t WS_WAOUT = 18 * MiB;
constexpr size_t WS_WBIN = 22 * MiB;
constexpr size_t WS_WBOUT = 30 * MiB;
constexpr size_t WS_WG = 34 * MiB;
constexpr size_t WS_WP = 42 * MiB;
constexpr size_t WS_SSQA = 44 * MiB, WS_SSQB = 46 * MiB;
constexpr size_t WS_CVBUF = 48 * MiB, WS_GBUF = 52 * MiB;
constexpr size_t WS_HB0 = 64 * MiB, WS_HB1 = 128 * MiB, WS_G = 192 * MiB, WS_PP = 256 * MiB, WS_END = 512 * MiB;
constexpr size_t WS_PB = WS_HB1;
constexpr size_t WS_HBUF = WS_PP, WS_FBUF = WS_PP + 32 * MiB;
constexpr int CW_BAR = 4096;
constexpr int RING_OFF = 0, RING_BYTES = 131072;
constexpr int LDSCTL_OFF = RING_BYTES, MISC_OFF = LDSCTL_OFF + 320;
constexpr int LDS_BYTES = 147456;

struct Frame {
    LAS unsigned char* lds;
    volatile LAS unsigned* MISC;
    int tid, lane, wave, vcu, G;
};
__device__ __forceinline__ float wave_sum(float v) {
#pragma unroll
    for (int o = 1; o < 64; o <<= 1) v += __shfl_xor(v, o);
    return v;
}
typedef unsigned v2u __attribute__((ext_vector_type(2)));
__device__ __forceinline__ unsigned pk_bf16(float lo, float hi) { return pg8::cvt_pk_bf16(lo, hi); }

template <int MAP> __device__ __forceinline__ int rowmap(int n) {
    if (MAP == 1) { const int type = n >> 10, e = n & 1023; return 256 * (e >> 6) + 128 * (type >> 1) + 32 * ((e & 63) >> 4) + 8 * ((e >> 2) & 3) + 4 * (type & 1) + (e & 3); }
    if (MAP == 2) { return 256 * (n >> 7) + 128 + (n & 127); }
    return n;
}
template <int MAP>
__device__ __forceinline__ void transpose_item(const float* W, int ldw, int ncols, int K, const float* gk, bf16* WT, LAS float* scr, int item, int lane) {
    const int nblk = ncols / 32, kb = item / nblk, nb = item % nblk, k0 = 64 * kb, n0 = 32 * nb;
#pragma unroll 8
    for (int i = 0; i < 32; ++i) { const int kk = 2 * i + (lane >> 5); float v = W[(size_t)(k0 + kk) * ldw + n0 + (lane & 31)]; if (gk) v *= gk[k0 + kk]; scr[kk * 33 + (lane & 31)] = v; }
    LDS_WAIT(); asm volatile("" ::: "memory");
    const int c = lane & 7;
#pragma unroll
    for (int j = 0; j < 4; ++j) { const int n = (lane >> 3) + 8 * j; const LAS float* s = scr + (8 * c) * 33 + n;
        v4u o; o.x = pk_bf16(s[0 * 33], s[1 * 33]); o.y = pk_bf16(s[2 * 33], s[3 * 33]); o.z = pk_bf16(s[4 * 33], s[5 * 33]); o.w = pk_bf16(s[6 * 33], s[7 * 33]);
        *(GAS v4u*)(WT + (size_t)rowmap<MAP>(n0 + n) * K + k0 + 8 * c) = o; }
    LDS_WAIT(); asm volatile("" ::: "memory");
}
typedef float f32x16 __attribute__((ext_vector_type(16)));
__device__ __forceinline__ void fold_item(const float* win  , const float* wgrp  , const float* nm, bf16* WT, int item, int lane) {
    const int g = item >> 8, kt = (item >> 3) & 31, dt = item & 7, k0 = 32 * kt, d0 = 32 * dt, h = lane >> 5, l31 = lane & 31;
    f32x16 acc;
#pragma unroll
    for (int q = 0; q < 16; ++q) acc[q] = 0.f;
    const float* arow = win + (size_t)(k0 + l31) * 2048 + g * 256 + 4 * h;
    const float* bcol = wgrp + (size_t)g * 65536 + (size_t)(4 * h) * 256 + d0 + l31;
#pragma unroll 4
    for (int c0 = 0; c0 < 256; c0 += 8) {
        const f32x4 a = *(const f32x4*)(arow + c0);
#pragma unroll
        for (int j = 0; j < 4; ++j) { const float b = bcol[(size_t)(c0 + j) * 256]; acc = __builtin_amdgcn_mfma_f32_32x32x2f32(a[j], b, acc, 0, 0, 0); }
    }
    const int e = g * 256 + d0 + l31; bf16* orow = WT + (size_t)(256 * (e >> 7) + (e & 127)) * 1024 + k0 + 4 * h;
#pragma unroll
    for (int qq = 0; qq < 4; ++qq) { const int kb = k0 + 8 * qq + 4 * h; const f32x4 gn = *(const f32x4*)(nm + kb);
        v2u o; o.x = pk_bf16(acc[4 * qq + 0] * gn[0], acc[4 * qq + 1] * gn[1]); o.y = pk_bf16(acc[4 * qq + 2] * gn[2], acc[4 * qq + 3] * gn[3]);
        *(GAS v2u*)(orow + 8 * qq) = o; }
}
template <int NR>
__device__ __forceinline__ void x_rows(const float* xrow, bf16* orow, float* ssq, int lane) {
    f32x4 v[NR][4];
#pragma unroll
    for (int r = 0; r < NR; ++r)
#pragma unroll
        for (int j = 0; j < 4; ++j) v[r][j] = *((const GAS f32x4*)(xrow + (size_t)r * D) + lane + 64 * j);
#pragma unroll
    for (int r = 0; r < NR; ++r) { float s = 0.f;
#pragma unroll
        for (int j = 0; j < 4; ++j) s += (v[r][j][0] * v[r][j][0] + v[r][j][1] * v[r][j][1]) + (v[r][j][2] * v[r][j][2] + v[r][j][3] * v[r][j][3]);
        s = wave_sum(s);
        GAS v2u* o8 = (GAS v2u*)(orow + (size_t)r * D) + lane;
#pragma unroll
        for (int j = 0; j < 4; ++j) { v2u o; o.x = pk_bf16(v[r][j][0], v[r][j][1]); o.y = pk_bf16(v[r][j][2], v[r][j][3]); o8[64 * j] = o; }
        if (lane < 16) ssq[r * 16 + lane] = lane == 0 ? s : 0.f; }
}
__device__ __forceinline__ void convert_p(const Frame& F, const float* p, bf16* pb) {
    const size_t n8 = (size_t)DEPTH * M * PLE / 8, stride = (size_t)F.G * NWAVES * 64;
    for (size_t i = (size_t)(F.vcu * NWAVES + F.wave) * 64 + F.lane; i < n8; i += 4 * stride) {
        f32x4 a[4], b[4];
#pragma unroll
        for (int k = 0; k < 4; ++k) { const size_t ii = i + k * stride; a[k] = *(const GAS f32x4*)(p + 8 * ii); b[k] = *(const GAS f32x4*)(p + 8 * ii + 4); }
#pragma unroll
        for (int k = 0; k < 4; ++k) { const size_t ii = i + k * stride;
            v4u o; o.x = pk_bf16(a[k][0], a[k][1]); o.y = pk_bf16(a[k][2], a[k][3]); o.z = pk_bf16(b[k][0], b[k][1]); o.w = pk_bf16(b[k][2], b[k][3]);
            *(GAS v4u*)(pb + 8 * ii) = o; }
    }
}
__device__ __forceinline__ float silu_f(float z) { return z * pg8::sigmoidf_fast(z); }

__device__ __forceinline__ void fixA_item(const float* wc0, const float* CVBUF, const float* GBUF, bf16* GB, int B, int q) {
    const int e0 = 4 * q;
    const f32x4 g0 = *(const GAS f32x4*)(GBUF + ((size_t)B * 2 + 0) * 1024 + e0), g1 = *(const GAS f32x4*)(GBUF + ((size_t)B * 2 + 1) * 1024 + e0);
    const f32x4 c1 = *(const GAS f32x4*)(CVBUF + ((size_t)(B - 1) * 2 + 1) * 1024 + e0), c2 = *(const GAS f32x4*)(CVBUF + ((size_t)(B - 1) * 2 + 0) * 1024 + e0);
    const f32x4 w0 = *(const GAS f32x4*)(wc0 + e0), w1 = *(const GAS f32x4*)(wc0 + 1024 + e0);
    GAS v2u* gp0 = (GAS v2u*)(GB + ((size_t)B * 64 + 0) * 1024 + e0); GAS v2u* gp1 = (GAS v2u*)(GB + ((size_t)B * 64 + 1) * 1024 + e0);
    const v2u x0 = *gp0, x1 = *gp1;
    const f32x4 a0 = g0 * (w0 * c2 + w1 * c1), a1 = g1 * (w0 * c1);
    v2u o0, o1; o0.x = pk_bf16(bf_lo(x0.x) + a0[0], bf_hi(x0.x) + a0[1]); o0.y = pk_bf16(bf_lo(x0.y) + a0[2], bf_hi(x0.y) + a0[3]);
    o1.x = pk_bf16(bf_lo(x1.x) + a1[0], bf_hi(x1.x) + a1[1]); o1.y = pk_bf16(bf_lo(x1.y) + a1[2], bf_hi(x1.y) + a1[3]);
    *gp0 = o0; *gp1 = o1;
}
template <int NR>
__device__ __forceinline__ void fixB_item(const float* HBUF, const float* FBUF, bf16* GB, int B, int q) {
    const int e0 = 4 * q;
    f32x4 h[NR], fz[NR]; v2u x[NR];
#pragma unroll
    for (int k = 0; k < NR; ++k) h[k] = *(const GAS f32x4*)(HBUF + ((size_t)(B - 1) * 15 + (15 - NR + k)) * 1024 + e0);
#pragma unroll
    for (int r = 0; r < NR; ++r) { fz[r] = *(const GAS f32x4*)(FBUF + ((size_t)B * 15 + r) * 1024 + e0); x[r] = *(const GAS v2u*)(GB + ((size_t)B * 64 + r) * 1024 + e0); }
    f32x4 S = (f32x4){0.f, 0.f, 0.f, 0.f};
#pragma unroll
    for (int r = NR - 1; r >= 0; --r) { S += h[r];
        const f32x4 a = fz[r] * S; v2u o; o.x = pk_bf16(bf_lo(x[r].x) + a[0], bf_hi(x[r].x) + a[1]); o.y = pk_bf16(bf_lo(x[r].y) + a[2], bf_hi(x[r].y) + a[3]);
        *(GAS v2u*)(GB + ((size_t)B * 64 + r) * 1024 + e0) = o; }
}
struct Args { const float* in[14]; float* out; unsigned char* ws; int ph_lo, ph_hi; };
constexpr int NPH = 2 + 4 * DEPTH;

__global__ void __launch_bounds__(NWAVES * 64, 2) mk_fwd(Args args) {
    extern __shared__ __attribute__((aligned(16))) unsigned char lds_raw[];
    Frame F;
    F.lds = (LAS unsigned char*)lds_raw;
    F.MISC = (volatile LAS unsigned*)(F.lds + MISC_OFF);
    F.tid = threadIdx.x; F.lane = F.tid & 63; F.wave = __builtin_amdgcn_readfirstlane(F.tid >> 6);
    F.G = gridDim.x; { const int bx = blockIdx.x; F.vcu = (F.G % 8 == 0) ? (bx % 8) * (F.G / 8) + bx / 8 : bx; }
    unsigned char* ws = args.ws;
    const float* x = args.in[0]; const float* p = args.in[1]; const float* norm_mix = args.in[2]; const float* a_w_in = args.in[3]; const float* a_w_conv = args.in[4];
    const float* a_w_out = args.in[5]; const float* b_w_in = args.in[6]; const float* b_w_grp = args.in[7]; const float* b_scale = args.in[8]; const float* b_w_out = args.in[9];
    const float* ple_norm = args.in[10]; const float* ple_w_gate = args.in[11]; const float* ple_w_proj = args.in[12]; const float* final_norm = args.in[13];
    float* out = args.out;
    bf16* WAin = (bf16*)(ws + WS_WAIN); bf16* WAout = (bf16*)(ws + WS_WAOUT); bf16* WBin = (bf16*)(ws + WS_WBIN); bf16* WBout = (bf16*)(ws + WS_WBOUT);
    bf16* WG = (bf16*)(ws + WS_WG); bf16* WP = (bf16*)(ws + WS_WP); float* SSQA = (float*)(ws + WS_SSQA); float* SSQB = (float*)(ws + WS_SSQB);
    bf16* PB = (bf16*)(ws + WS_PB); bf16* HB0 = (bf16*)(ws + WS_HB0); bf16* HB1 = (bf16*)(ws + WS_HB1); bf16* GB = (bf16*)(ws + WS_G); bf16* PP = (bf16*)(ws + WS_PP);
    float* CVBUF = (float*)(ws + WS_CVBUF); float* GBUF = (float*)(ws + WS_GBUF); float* HBUF = (float*)(ws + WS_HBUF); float* FBUF = (float*)(ws + WS_FBUF);

    for (int u = F.tid; u < (LDS_BYTES - LDSCTL_OFF) / 4; u += NWAVES * 64) ((LAS unsigned*)(F.lds + LDSCTL_OFF))[u] = 0u;
    __syncthreads();
    XcdBarrier bar; bar.bar = (unsigned*)(ws + WS_CTL) + CW_BAR; bar.x = 0; bar.st = nullptr;
    if (!MK_MULTI) bar = xcd_barrier_post((unsigned*)(ws + WS_CTL) + CW_BAR, F.MISC + 8);

    for (int ph = args.ph_lo; ph < args.ph_hi; ++ph) {
        { int t_ = threadIdx.x; asm volatile("" : "+v"(t_)); F.tid = t_; F.lane = t_ & 63; F.wave = __builtin_amdgcn_readfirstlane(t_ >> 6); }
        const int gw = F.vcu * NWAVES + F.wave, NGW = F.G * NWAVES;
        if (ph == 0) { REP(1) {
            LAS float* scr = (LAS float*)(F.lds + RING_OFF + F.wave * 16384);
            constexpr int I_AIN = 16 * 128, I_SQ = 16 * 32, I_WP = 4 * 32, I_FOLD = 1024;
            constexpr int N_AIN = 2 * I_AIN, N_AOUT = 2 * I_SQ, N_BZ = 2 * I_SQ, N_BOUT = 2 * I_SQ, N_WG = 4 * I_SQ, N_WP = 4 * I_WP, N_FOLD = 2 * I_FOLD;
            constexpr int NITEMS = N_FOLD + N_AIN + N_AOUT + N_BZ + N_BOUT + N_WG + N_WP;
            for (int it = gw; it < NITEMS; it += NGW) {
                int r = it;
                if (r < N_FOLD) { const int j = r / I_FOLD; fold_item(b_w_in + (size_t)j * 1024 * 2048, b_w_grp + (size_t)j * 4 * 65536, norm_mix + (2 * j + 1) * 1024, WBin + (size_t)j * 2048 * 1024, r % I_FOLD, F.lane); continue; } r -= N_FOLD;
                if (r < N_AIN) { const int j = r / I_AIN; transpose_item<1>(a_w_in + (size_t)j * 1024 * 4096, 4096, 4096, 1024, norm_mix + (2 * j) * 1024, WAin + (size_t)j * 4096 * 1024, scr, r % I_AIN, F.lane); continue; } r -= N_AIN;
                if (r < N_AOUT) { const int j = r / I_SQ; transpose_item<0>(a_w_out + (size_t)j * 1024 * 1024, 1024, 1024, 1024, nullptr, WAout + (size_t)j * 1024 * 1024, scr, r % I_SQ, F.lane); continue; } r -= N_AOUT;
                if (r < N_BZ) { const int j = r / I_SQ; transpose_item<2>(b_w_in + (size_t)j * 1024 * 2048 + 1024, 2048, 1024, 1024, norm_mix + (2 * j + 1) * 1024, WBin + (size_t)j * 2048 * 1024, scr, r % I_SQ, F.lane); continue; } r -= N_BZ;
                if (r < N_BOUT) { const int j = r / I_SQ; transpose_item<0>(b_w_out + (size_t)j * 1024 * 1024, 1024, 1024, 1024, nullptr, WBout + (size_t)j * 1024 * 1024, scr, r % I_SQ, F.lane); continue; } r -= N_BOUT;
                if (r < N_WG) { const int j = r / I_SQ; transpose_item<0>(ple_w_gate + (size_t)j * 1024 * 1024, 1024, 1024, 1024, ple_norm + j * 1024, WG + (size_t)j * 1024 * 1024, scr, r % I_SQ, F.lane); continue; } r -= N_WG;
                { const int j = r / I_WP; transpose_item<0>(ple_w_proj + (size_t)j * 256 * 1024, 1024, 1024, 256, nullptr, WP + (size_t)j * 1024 * 256, scr, r % I_WP, F.lane); }
            }
            for (int m = 4 * gw; m < M; m += 4 * NGW) x_rows<4>(x + (size_t)m * D, HB0 + (size_t)m * D, SSQB + (size_t)m * 16, F.lane);
            convert_p(F, p, PB); }
        } else if (ph == NPH - 1) { REP(64) {
            f32x4 gn[4];
#pragma unroll
            for (int j = 0; j < 4; ++j) gn[j] = *((const GAS f32x4*)final_norm + F.lane + 64 * j);
            for (int m = 4 * gw; m < M; m += 4 * NGW) {
                v2u hw[4][4]; float sq[4];
#pragma unroll
                for (int r = 0; r < 4; ++r) { sq[r] = F.lane < 16 ? SSQB[(size_t)(m + r) * 16 + F.lane] : 0.f;
#pragma unroll
                    for (int j = 0; j < 4; ++j) hw[r][j] = *((const GAS v2u*)(HB0 + (size_t)(m + r) * D) + F.lane + 64 * j); }
#pragma unroll
                for (int r = 0; r < 4; ++r) { float t = sq[r]; t += __shfl_xor(t, 1); t += __shfl_xor(t, 2); t += __shfl_xor(t, 4); t += __shfl_xor(t, 8); t = __shfl(t, 0);
                    const float rs = __builtin_amdgcn_rsqf(t * (1.0f / 1024.0f) + 1e-6f);
                    GAS f32x4* orow = (GAS f32x4*)(out + (size_t)(m + r) * D) + F.lane;
#pragma unroll
                    for (int j = 0; j < 4; ++j) { f32x4 o; o[0] = bf_lo(hw[r][j].x) * rs * gn[j][0]; o[1] = bf_hi(hw[r][j].x) * rs * gn[j][1]; o[2] = bf_lo(hw[r][j].y) * rs * gn[j][2]; o[3] = bf_hi(hw[r][j].y) * rs * gn[j][3]; orow[64 * j] = o; } }
            } }
        } else {
            const int i = (ph - 1) >> 2, s = (ph - 1) & 3, j = i >> 1; const bool isA = (i & 1) == 0;
            if (s == 0) {
                if (i == 0) REP(2) {
                    pg8::Gemm g{PB, WP, DEPTH * M, DEPTH * D, PLE}; pg8::PPOrder S; S.init(F.G, (int)blockIdx.x);
                    pg8::EpiPP E{PP};
                    pg8::gemm_phase<pg8::EpiPP, pg8::PPOrder, true, true>(F.lds + RING_OFF, g, S, E);
                }
                if (isA) REP(4) {
                    pg8::Gemm g{HB0, WAin + (size_t)j * 4096 * 1024, M, 4096, D}; pg8::StaticOrder S; S.init(M, 4096, F.G, (int)blockIdx.x);
                    pg8::EpiConvA E{GB, SSQB, a_w_conv + (size_t)j * 3 * 1024, CVBUF, GBUF};
                    pg8::gemm_phase<pg8::EpiConvA, pg8::StaticOrder, true, true>(F.lds + RING_OFF, g, S, E);
                } else REP(8) {
                    pg8::Gemm g{HB0, WBin + (size_t)j * 2048 * 1024, M, 2048, D}; pg8::StaticOrder S; S.init(M, 2048, F.G, (int)blockIdx.x);
                    pg8::EpiPoolB E{GB, SSQB, b_scale + (size_t)j * 1024, HBUF, FBUF};
                    pg8::gemm_phase<pg8::EpiPoolB, pg8::StaticOrder, true, true>(F.lds + RING_OFF, g, S, E);
                }
            } else if (s == 1) {
                const size_t gt = (size_t)blockIdx.x * (NWAVES * 64) + F.tid, GT = (size_t)F.G * NWAVES * 64;
                if (isA) {
                    const float* wc0 = a_w_conv + (size_t)j * 3 * 1024;
                    for (size_t idx = gt; idx < (size_t)512 * 256; idx += GT) { const int q = (int)(idx & 255), B = (int)(idx >> 8);
                        if ((B & 63) != 0) fixA_item(wc0, CVBUF, GBUF, GB, B, q); }
                } else {
                    for (size_t idx = gt; idx < (size_t)512 * 256; idx += GT) { const int q = (int)(idx & 255), B = (int)(idx >> 8), g = q >> 6;
                        if ((B & 63) == 0) continue;
                        if (g == 0) fixB_item<1>(HBUF, FBUF, GB, B, q); else if (g == 1) fixB_item<3>(HBUF, FBUF, GB, B, q); else if (g == 2) fixB_item<7>(HBUF, FBUF, GB, B, q); else fixB_item<15>(HBUF, FBUF, GB, B, q); }
                }
            } else if (s == 2) { REP(16) {
                pg8::Gemm g{GB, isA ? WAout + (size_t)j * 1024 * 1024 : WBout + (size_t)j * 1024 * 1024, M, D, D}; pg8::StaticOrder S; S.init(M, D, F.G, (int)blockIdx.x);
                pg8::EpiResid E{HB0, HB1, SSQA};
#if PROBE_REP & 512
                pg8::gemm_phase<pg8::EpiResid, pg8::StaticOrder, true, true>(F.lds + RING_OFF, g, S, E);
                { pg8::EpiNull EN{SSQB}; pg8::gemm_phase<pg8::EpiNull, pg8::StaticOrder, true, true>(F.lds + RING_OFF, g, S, EN); }
#elif PROBE_REP & 256
                for (int hf = 0; hf < 2; ++hf) { S.i0 = hf; S.cnt = 1; pg8::gemm_phase<pg8::EpiResid, pg8::StaticOrder, true, true>(F.lds + RING_OFF, g, S, E); if (hf == 0) xcd_barrier(bar); }
#else
                pg8::gemm_phase<pg8::EpiResid, pg8::StaticOrder, true, true>(F.lds + RING_OFF, g, S, E);
#endif
                }
            } else { REP(32) {
                pg8::Gemm g{HB1, WG + (size_t)i * 1024 * 1024, M, D, D}; pg8::StaticOrder S; S.init(M, D, F.G, (int)blockIdx.x);
                pg8::EpiPle E{HB1, HB0, PP + (size_t)i * M * D, SSQA, SSQB};
                pg8::gemm_phase<pg8::EpiPle, pg8::StaticOrder, true, true>(F.lds + RING_OFF, g, S, E); }
            }
        }
        if (ph + 1 < args.ph_hi) REP(128) xcd_barrier(bar);
    }
}

extern "C" void kernel_launch(void* const* d_in, const int* in_sizes, int n_in, void* d_out, int out_size, void* d_ws, size_t ws_size, hipStream_t stream) {
    static int grid = 0;
    if (grid == 0) {
        if (n_in != 14 || in_sizes[0] != M * D || out_size != M * D || ws_size < WS_END) { fprintf(stderr, "kernel_launch: unexpected shapes (n_in %d, in0 %d, out %d, ws %zu); nothing launched\n", n_in, n_in > 0 ? in_sizes[0] : -1, out_size, ws_size); grid = -1; return; }
        int dev = 0, cus = 0, per_cu = 0;
        if (hipGetDevice(&dev) != hipSuccess || hipDeviceGetAttribute(&cus, hipDeviceAttributeMultiprocessorCount, dev) != hipSuccess) { grid = -1; return; }
        if (hipFuncSetAttribute((const void*)mk_fwd, hipFuncAttributeMaxDynamicSharedMemorySize, LDS_BYTES) != hipSuccess) { fprintf(stderr, "kernel_launch: hipFuncSetAttribute failed\n"); grid = -1; return; }
        if (hipOccupancyMaxActiveBlocksPerMultiprocessor(&per_cu, (const void*)mk_fwd, NWAVES * 64, LDS_BYTES) != hipSuccess || per_cu < 1) { fprintf(stderr, "kernel_launch: occupancy query says %d blocks per CU\n", per_cu); per_cu = 1; }
        (void)hipGetLastError();
        grid = cus;
    }
    if (grid < 0) return;
    (void)hipMemsetAsync((char*)d_ws + WS_CTL, 0, CTL_ZERO_BYTES, stream);
    Args a{};
    for (int i = 0; i < 14; ++i) a.in[i] = (const float*)d_in[i];
    a.out = (float*)d_out; a.ws = (unsigned char*)d_ws;
#if MK_MULTI
    for (int ph = 0; ph < NPH; ++ph) { a.ph_lo = ph; a.ph_hi = ph + 1; hipLaunchKernelGGL(mk_fwd, dim3(grid), dim3(NWAVES * 64), LDS_BYTES, stream, a); }
#else
    a.ph_lo = 0; a.ph_hi = NPH;
    hipLaunchKernelGGL(mk_fwd, dim3(grid), dim3(NWAVES * 64), LDS_BYTES, stream, a);
#endif
}
```
